# Optimizing an MI355X kernel written in HIP

```python
import math
import jax, jax.numpy as jnp
from jax import lax
import numpy as np

D_MODEL = 2048
BATCH = 2
SEQ = 4096
DEPTH = 4

EXPAND = 2
D_INNER = EXPAND * D_MODEL
N_MIXERS = 2
POOL_WINDOWS = (2, 4, 8, 16)
POOL_GROUPS = len(POOL_WINDOWS)
POOL_GROUP_DIM = D_INNER // POOL_GROUPS
SSM_GROUP_DIM = 16
SSM_GROUPS = D_INNER // SSM_GROUP_DIM
SSM_STATE = 64
SSM_GROUP_CHUNK = 32
SSM_N_CHUNKS = SSM_GROUPS // SSM_GROUP_CHUNK
DT_MIN = 1e-3
DT_MAX = 1e-1
NORM_EPS = 1e-6
N_POOL_LAYERS = (DEPTH + 1) // 2
N_SSM_LAYERS = DEPTH // 2

kernel_name = "hybrid_pool_s5_interleaved"


def _rmsnorm(x, g):
    x32 = x.astype(jnp.float32)
    inv = lax.rsqrt(jnp.mean(x32 * x32, axis=-1, keepdims=True) + NORM_EPS)
    return (x32 * inv * g.astype(jnp.float32)).astype(x.dtype)


def _pool_mixer(u, w_grp, scale):
    b, l, _ = u.shape
    u32 = u.astype(jnp.float32)
    cs = jnp.cumsum(u32, axis=1)
    pos = jnp.arange(l)
    outs = []
    for g, w in enumerate(POOL_WINDOWS):
        sl = slice(g * POOL_GROUP_DIM, (g + 1) * POOL_GROUP_DIM)
        csg = cs[..., sl]
        lag = jnp.pad(csg, ((0, 0), (w, 0), (0, 0)))[:, :l]
        cnt = jnp.minimum(pos + 1, w).astype(jnp.float32)[None, :, None]
        outs.append((csg - lag) / cnt - u32[..., sl])
    p = jnp.stack(outs, axis=2)
    m = jnp.einsum('blgc,gcd->blgd', p, w_grp.astype(jnp.float32)).reshape(b, l, D_INNER)
    return m * scale.astype(jnp.float32)


def _cplx_linrec(e1, e2):
    a1r, a1i, b1r, b1i = e1
    a2r, a2i, b2r, b2i = e2
    ar = a2r * a1r - a2i * a1i
    ai = a2r * a1i + a2i * a1r
    br = a2r * b1r - a2i * b1i + b2r
    bi = a2r * b1i + a2i * b1r + b2i
    return (ar, ai, br, bi)


def _ssm_chunk(args):
    u_c, abr, abi, bbr, bbi, cr, ci = args
    bu_r = jnp.einsum('blgp,gnp->blgn', u_c, bbr)
    bu_i = jnp.einsum('blgp,gnp->blgn', u_c, bbi)
    ar = jnp.broadcast_to(abr, bu_r.shape)
    ai = jnp.broadcast_to(abi, bu_r.shape)
    _, _, hr, hi = lax.associative_scan(_cplx_linrec, (ar, ai, bu_r, bu_i), axis=1)
    return jnp.einsum('blgn,gpn->blgp', hr, cr) - jnp.einsum('blgn,gpn->blgp', hi, ci)


def _s5_mixer(u, a_re, a_im, log_dt, b_re, b_im, c_re, c_im, d_skip, w_glu, b_glu):
    f32 = jnp.float32
    b, l, _ = u.shape
    u32 = u.astype(f32)
    a_re = a_re.astype(f32); a_im = a_im.astype(f32)
    dt = jnp.exp(log_dt.astype(f32))[:, None]
    mag = jnp.exp(a_re * dt)
    abr = mag * jnp.cos(a_im * dt)
    abi = mag * jnp.sin(a_im * dt)
    den = a_re * a_re + a_im * a_im
    nr = abr - 1.0
    fr = (nr * a_re + abi * a_im) / den
    fi = (abi * a_re - nr * a_im) / den
    b_re = b_re.astype(f32); b_im = b_im.astype(f32)
    bbr = fr[..., None] * b_re - fi[..., None] * b_im
    bbi = fr[..., None] * b_im + fi[..., None] * b_re
    nc, gc = SSM_N_CHUNKS, SSM_GROUP_CHUNK
    u_ch = u32.reshape(b, l, nc, gc, SSM_GROUP_DIM).transpose(2, 0, 1, 3, 4)
    y = lax.map(_ssm_chunk, (u_ch,
                             abr.reshape(nc, gc, SSM_STATE), abi.reshape(nc, gc, SSM_STATE),
                             bbr.reshape(nc, gc, SSM_STATE, SSM_GROUP_DIM),
                             bbi.reshape(nc, gc, SSM_STATE, SSM_GROUP_DIM),
                             c_re.astype(f32).reshape(nc, gc, SSM_GROUP_DIM, SSM_STATE),
                             c_im.astype(f32).reshape(nc, gc, SSM_GROUP_DIM, SSM_STATE)))
    y = y.transpose(1, 2, 0, 3, 4).reshape(b, l, D_INNER) + d_skip.astype(f32) * u32
    g = jax.nn.gelu(y)
    return g * jax.nn.sigmoid(g @ w_glu.astype(f32) + b_glu.astype(f32))


def setup_inputs(seed: int = 0) -> dict:
    key = jax.random.key(seed)
    ks = jax.random.split(key, 24)
    f32 = jnp.float32
    D, E, G, N, P = D_MODEL, D_INNER, SSM_GROUPS, SSM_STATE, SSM_GROUP_DIM
    NP_, NS_ = N_POOL_LAYERS, N_SSM_LAYERS
    nrm = lambda k, s, sc: jax.random.normal(k, s, f32) * sc
    x = jax.random.normal(ks[0], (BATCH, SEQ, D), f32)
    norm_g = 1.0 + nrm(ks[1], (DEPTH, D), 0.02)
    final_norm_g = 1.0 + nrm(ks[2], (D,), 0.02)
    pool_w_in = nrm(ks[3], (NP_, D, 2 * E), D ** -0.5)
    pool_w_grp = nrm(ks[4], (NP_, POOL_GROUPS, POOL_GROUP_DIM, POOL_GROUP_DIM), POOL_GROUP_DIM ** -0.5)
    pool_scale = 1.0 + nrm(ks[5], (NP_, E), 0.02)
    pool_w_out = nrm(ks[6], (NP_, E, D), E ** -0.5)
    ssm_w_in = nrm(ks[7], (NS_, D, 2 * E), D ** -0.5)
    n_idx = jnp.arange(N, dtype=f32)
    ssm_a_re = -0.5 + nrm(ks[8], (NS_, G, N), 0.01)
    ssm_a_im = math.pi * n_idx[None, None, :] + nrm(ks[9], (NS_, G, N), 0.01)
    ssm_log_dt = math.log(DT_MIN) + jax.random.uniform(ks[10], (NS_, G), f32) * (math.log(DT_MAX) - math.log(DT_MIN))
    ssm_b_re = nrm(ks[11], (NS_, G, N, P), (2.0 * P) ** -0.5)
    ssm_b_im = nrm(ks[12], (NS_, G, N, P), (2.0 * P) ** -0.5)
    ssm_c_re = nrm(ks[13], (NS_, G, P, N), (2.0 * N) ** -0.5)
    ssm_c_im = nrm(ks[14], (NS_, G, P, N), (2.0 * N) ** -0.5)
    ssm_d = nrm(ks[15], (NS_, E), 1.0)
    ssm_w_glu = nrm(ks[16], (NS_, E, E), E ** -0.5)
    ssm_b_glu = nrm(ks[17], (NS_, E), 0.02)
    ssm_w_out = nrm(ks[18], (NS_, E, D), E ** -0.5)
    return {"x": x, "norm_g": norm_g, "final_norm_g": final_norm_g,
            "pool_w_in": pool_w_in, "pool_w_grp": pool_w_grp, "pool_scale": pool_scale, "pool_w_out": pool_w_out,
            "ssm_w_in": ssm_w_in, "ssm_a_re": ssm_a_re, "ssm_a_im": ssm_a_im, "ssm_log_dt": ssm_log_dt,
            "ssm_b_re": ssm_b_re, "ssm_b_im": ssm_b_im, "ssm_c_re": ssm_c_re, "ssm_c_im": ssm_c_im,
            "ssm_d": ssm_d, "ssm_w_glu": ssm_w_glu, "ssm_b_glu": ssm_b_glu, "ssm_w_out": ssm_w_out}


def reference(x, norm_g, final_norm_g, pool_w_in, pool_w_grp, pool_scale, pool_w_out,
              ssm_w_in, ssm_a_re, ssm_a_im, ssm_log_dt, ssm_b_re, ssm_b_im, ssm_c_re, ssm_c_im,
              ssm_d, ssm_w_glu, ssm_b_glu, ssm_w_out):
    for i in range(DEPTH):
        h = _rmsnorm(x, norm_g[i])
        j = i // N_MIXERS
        if i % N_MIXERS == 0:
            uz = h @ pool_w_in[j]
            u, z = uz[..., :D_INNER], uz[..., D_INNER:]
            y = _pool_mixer(u, pool_w_grp[j], pool_scale[j])
            w_out = pool_w_out[j]
        else:
            uz = h @ ssm_w_in[j]
            u, z = uz[..., :D_INNER], uz[..., D_INNER:]
            y = _s5_mixer(u, ssm_a_re[j], ssm_a_im[j], ssm_log_dt[j], ssm_b_re[j], ssm_b_im[j],
                          ssm_c_re[j], ssm_c_im[j], ssm_d[j], ssm_w_glu[j], ssm_b_glu[j])
            w_out = ssm_w_out[j]
        gated = (y * jax.nn.silu(z.astype(jnp.float32))).astype(x.dtype)
        x = x + (gated @ w_out).astype(x.dtype)
    return _rmsnorm(x, final_norm_g)
```

```cpp
#include <hip/hip_runtime.h>
#include <hip/hip_cooperative_groups.h>
#include <cstdio>
namespace cg = cooperative_groups;

#ifndef ONE_LAUNCH
#define ONE_LAUNCH 0
#endif

#define LAS __attribute__((address_space(3)))
typedef unsigned short bf16_t;
typedef short bf16x8 __attribute__((ext_vector_type(8)));
typedef float f32x4 __attribute__((ext_vector_type(4)));
typedef float f32x2 __attribute__((ext_vector_type(2)));
typedef unsigned u32x4 __attribute__((ext_vector_type(4)));
typedef unsigned u32x2 __attribute__((ext_vector_type(2)));

constexpr int M_TOK = 8192, SEQ = 4096, DM = 2048, DE = 4096, DE2 = 8192;
constexpr int NG = 256, NS = 64, NP = 16, TCH = 16, NCH = SEQ / TCH;
constexpr float EPS = 1e-6f;
constexpr int NTHREADS = 512;
constexpr int LDS_BYTES = 131072;

constexpr size_t MiB = 1024 * 1024;
constexpr size_t WS_HBF = 0;
constexpr size_t WS_UZ = WS_HBF + 32 * MiB;
constexpr size_t WS_PG = WS_UZ + 128 * MiB;
constexpr size_t WS_GATED = WS_PG + 64 * MiB;
constexpr size_t WS_W = WS_GATED + 64 * MiB;
constexpr size_t W_POOL_IN = 0, W_POOL_GRP = 32 * MiB, W_POOL_OUT = 40 * MiB, W_POOL_SZ = 56 * MiB;
constexpr size_t W_SSM_IN = 0, W_SSM_GLU = 32 * MiB, W_SSM_OUT = 64 * MiB, W_SSM_SZ = 80 * MiB;
constexpr size_t WS_WSSM = WS_W + 2 * W_POOL_SZ;
constexpr size_t WS_ROWSS = WS_WSSM + 2 * W_SSM_SZ;
constexpr size_t WS_END = WS_ROWSS + 1 * MiB;

struct Params {
    const float* in[19];
    float* out;
    unsigned char* ws;
    int ph_lo, ph_hi;
};

typedef const __attribute__((address_space(4))) Params* ParamsPtr;
__device__ __forceinline__ ParamsPtr params_ptr() { ParamsPtr q = (ParamsPtr)__builtin_amdgcn_kernarg_segment_ptr(); asm volatile("" : "+s"(q)); return q; }
__device__ __forceinline__ int fresh_tid() { int t = threadIdx.x; asm volatile("" : "+v"(t)); return t; }

__device__ __forceinline__ unsigned cvt_pk_bf16(float lo, float hi) { unsigned r; asm volatile("v_cvt_pk_bf16_f32 %0, %1, %2" : "=v"(r) : "v"(lo), "v"(hi)); return r; }
__device__ __forceinline__ float bf_lo(unsigned w) { return __uint_as_float(w << 16); }
__device__ __forceinline__ float bf_hi(unsigned w) { return __uint_as_float(w & 0xffff0000u); }
__device__ __forceinline__ float bf2f(bf16_t b) { return __uint_as_float(((unsigned)b) << 16); }
__device__ __forceinline__ float fast_rcp(float x) { return __builtin_amdgcn_rcpf(x); }
__device__ __forceinline__ float silu_f(float z) { return z * fast_rcp(1.0f + __expf(-z)); }
__device__ __forceinline__ float sigmoid_f(float z) { return fast_rcp(1.0f + __expf(-z)); }
__device__ __forceinline__ float gelu_tanh_f(float y) {
    const float a = 0.7978845608028654f * (y + 0.044715f * y * y * y);
    const float e = __expf(2.0f * a);
    const float th = 1.0f - 2.0f * fast_rcp(e + 1.0f);
    return 0.5f * y * (1.0f + th);
}

namespace pg8 {
constexpr int BM = 256, BK = 64, HALF = 128, HTB = HALF * BK * 2, STAGE_BYTES = 8 * HTB, NXCD = 8, WGM = 8;
__host__ __device__ __forceinline__ int lds_byte(int r, int c) { const int st = (r >> 4) * 2 + (c >> 5), rr = r & 15, cc = c & 31, ob = rr * 64 + cc * 2; return st * 1024 + (ob ^ (((ob >> 9) & 1) << 5)); }
__host__ __device__ __forceinline__ void stage_rc(int b, int& R, int& C) { const int st = b / 1024, sb = b % 1024, swz = sb ^ (((sb >> 9) & 1) << 5); R = (st >> 1) * 16 + swz / 64; C = (st & 1) * 32 + (swz % 64) / 2; }
__host__ __device__ __forceinline__ int perm32(int rho) { const int n = rho >> 4, i = rho & 15; return 8 * (i >> 2) + 4 * n + (i & 3); }

struct Unit { int pm, pn; };
struct Gemm { const bf16_t* A; const bf16_t* Bt; int M, N, K, lda, grouped; };

struct StaticOrder {
    int nM, nN, nwg, G, c;
    __device__ void init(int M, int N, int G_, int c_) { nM = M / BM; nN = N / BM; nwg = nM * nN; G = G_; c = c_; }
    __device__ bool next(int i, Unit& u) const {
        const long L = (long)i * G + c; if (L >= nwg) return false;
        int wgid = (int)L; { const int q = nwg / NXCD, r = nwg % NXCD, xcd = wgid % NXCD, off = wgid / NXCD; wgid = (xcd < r ? xcd * (q + 1) : r * (q + 1) + (xcd - r) * q) + off; }
        const int nig = WGM * nN, gid = wgid / nig, fm = gid * WGM, gsz = (nM - fm) < WGM ? (nM - fm) : WGM;
        u.pm = fm + ((wgid % nig) % gsz); u.pn = (wgid % nig) / gsz; return true;
    }
};

template <class Epi>
__device__ __forceinline__ void gemm_phase(LAS unsigned char* lds, const Gemm g, const StaticOrder& S, const Epi& E) {
    const int tid = fresh_tid(), wid = __builtin_amdgcn_readfirstlane(tid >> 6), lane = tid & 63, wr = wid >> 2, wc = wid & 3, fr = lane & 15, fq = lane >> 4;
    const int K = g.K, nt = K / BK, lda = g.lda;
    unsigned voffA[2], voffB[2];
#pragma unroll
    for (int i = 0; i < 2; ++i) { int R, C; stage_rc(tid * 16 + i * 8192, R, C); const int Rb = Epi::PERM ? ((R & ~31) + perm32(R & 31)) : R;
        voffA[i] = (unsigned)(R * lda + C) * 2u; voffB[i] = (unsigned)(Rb * K + C) * 2u; }
    const size_t kstep = (size_t)(BK * 2);
    const size_t hstepA = (size_t)HALF * lda * 2, hstepB = (size_t)HALF * K * 2;
    const size_t tstepA = 2 * hstepA, tstepB = 2 * hstepB;
    const size_t gstepA = g.grouped ? (size_t)K * 2 : 0;
    const unsigned ldsw = (unsigned)wid * 1024u;
    const int aoff = lds_byte(wr * 64 + fr, fq * 8), boff = lds_byte(wc * 32 + fr, fq * 8);
#define PG8_SA(b, h) (((b) * 2 + (h)) * HTB)
#define PG8_SB(b, h) ((4 + (b) * 2 + (h)) * HTB)
#define PG8_STAGE(bufoff, gbase, voff) do { _Pragma("unroll") for (int _i = 0; _i < 2; ++_i) \
        __builtin_amdgcn_global_load_lds((const unsigned*)((const char*)(gbase) + (voff)[_i]), (LAS unsigned*)(lds + (bufoff) + ldsw + _i * 8192), 16, 0, 0); } while (0)
#define PG8_LDA(dst, b, h) do { _Pragma("unroll") for (int m = 0; m < 4; ++m) _Pragma("unroll") for (int k = 0; k < 2; ++k) dst[m][k] = *(const LAS bf16x8*)(lds + PG8_SA(b, h) + aoff + m * 2048 + k * 1024); } while (0)
#define PG8_LDB(dst, b, h) do { _Pragma("unroll") for (int n = 0; n < 2; ++n) _Pragma("unroll") for (int k = 0; k < 2; ++k) dst[n][k] = *(const LAS bf16x8*)(lds + PG8_SB(b, h) + boff + n * 2048 + k * 1024); } while (0)
#define PG8_MMA(ai, bj, At, Bt) do { __builtin_amdgcn_s_setprio(1); _Pragma("unroll") for (int m = 0; m < 4; ++m) _Pragma("unroll") for (int n = 0; n < 2; ++n) _Pragma("unroll") for (int k = 0; k < 2; ++k) \
        acc[ai][bj][m][n] = __builtin_amdgcn_mfma_f32_16x16x32_bf16(Bt[n][k], At[m][k], acc[ai][bj][m][n], 0, 0, 0); __builtin_amdgcn_s_setprio(0); } while (0)
#define PG8_WAIT_V(n) asm volatile("s_waitcnt vmcnt(" #n ")" ::: "memory")
#define PG8_WAIT_L(n) asm volatile("s_waitcnt lgkmcnt(" #n ")" ::: "memory")
#define PG8_BAR __builtin_amdgcn_s_barrier()
#define PG8_SCHED __builtin_amdgcn_sched_barrier(0)
    Unit cur, nxt; int ui = 0;
    if (!S.next(0, cur)) return;
    f32x4 acc[2][2][4][2];
#pragma unroll
    for (int a = 0; a < 2; ++a)
#pragma unroll
        for (int b = 0; b < 2; ++b)
#pragma unroll
            for (int m = 0; m < 4; ++m)
#pragma unroll
                for (int n = 0; n < 2; ++n) acc[a][b][m][n] = (f32x4){0.f, 0.f, 0.f, 0.f};
    bf16x8 At[4][2], B0[2][2], B1[2][2];
    const char* cA = (const char*)g.A + (size_t)cur.pm * tstepA + (size_t)(cur.pn >> 2) * gstepA; const char* cB = (const char*)g.Bt + (size_t)cur.pn * tstepB;
    PG8_STAGE(PG8_SB(0, 0), cB, voffB); PG8_STAGE(PG8_SA(0, 0), cA, voffA); PG8_STAGE(PG8_SB(0, 1), cB + hstepB, voffB); PG8_STAGE(PG8_SA(0, 1), cA + hstepA, voffA);
    if (wr == 1) PG8_BAR;
    PG8_WAIT_V(4); PG8_BAR;
    PG8_STAGE(PG8_SB(1, 0), cB + kstep, voffB); PG8_STAGE(PG8_SA(1, 0), cA + kstep, voffA); PG8_STAGE(PG8_SB(1, 1), cB + hstepB + kstep, voffB);
    PG8_WAIT_V(6); PG8_BAR;
    for (;;) {
        const bool has_next = S.next(ui + 1, nxt);
        const char* nA = has_next ? (const char*)g.A + (size_t)nxt.pm * tstepA + (size_t)(nxt.pn >> 2) * gstepA : cA; const char* nB = has_next ? (const char*)g.Bt + (size_t)nxt.pn * tstepB : cB;
        for (int t = 0; t < nt; t += 2) {
            const bool last = (t == nt - 2);
            const char* a1 = cA + (size_t)(t + 1) * kstep;
            const char* a2 = last ? nA : cA + (size_t)(t + 2) * kstep; const char* b2 = last ? nB : cB + (size_t)(t + 2) * kstep;
            const char* a3 = a2 + kstep; const char* b3 = b2 + kstep;
            PG8_LDB(B0, 0, 0); PG8_SCHED; PG8_LDA(At, 0, 0); PG8_STAGE(PG8_SA(1, 1), a1 + hstepA, voffA);
            PG8_WAIT_L(8); PG8_BAR; PG8_WAIT_L(0); PG8_MMA(0, 0, At, B0); PG8_BAR; PG8_SCHED;
            PG8_LDB(B1, 0, 1); PG8_STAGE(PG8_SB(0, 0), b2, voffB);
            PG8_BAR; PG8_WAIT_L(0); PG8_MMA(0, 1, At, B1); PG8_BAR;
            PG8_LDA(At, 0, 1); PG8_STAGE(PG8_SA(0, 0), a2, voffA);
            PG8_BAR; PG8_WAIT_L(0); PG8_MMA(1, 0, At, B0); PG8_BAR; PG8_SCHED;
            PG8_STAGE(PG8_SB(0, 1), b2 + hstepB, voffB);
            PG8_WAIT_V(6); PG8_BAR; PG8_MMA(1, 1, At, B1); PG8_BAR;
            PG8_LDB(B0, 1, 0); PG8_SCHED; PG8_LDA(At, 1, 0); PG8_STAGE(PG8_SA(0, 1), a2 + hstepA, voffA);
            PG8_WAIT_L(8); PG8_BAR; PG8_WAIT_L(0); PG8_MMA(0, 0, At, B0); PG8_BAR; PG8_SCHED;
            PG8_LDB(B1, 1, 1); PG8_STAGE(PG8_SB(1, 0), b3, voffB);
            PG8_BAR; PG8_WAIT_L(0); PG8_MMA(0, 1, At, B1); PG8_BAR;
            PG8_LDA(At, 1, 1); PG8_STAGE(PG8_SA(1, 0), a3, voffA);
            PG8_BAR; PG8_WAIT_L(0); PG8_MMA(1, 0, At, B0); PG8_BAR; PG8_SCHED;
            PG8_STAGE(PG8_SB(1, 1), b3 + hstepB, voffB);
            PG8_WAIT_V(6); PG8_BAR; PG8_MMA(1, 1, At, B1); PG8_BAR;
        }
        E(acc, cur, wr, wc, fr, fq);
        if (!has_next) break;
#pragma unroll
        for (int a = 0; a < 2; ++a)
#pragma unroll
            for (int b = 0; b < 2; ++b)
#pragma unroll
                for (int m = 0; m < 4; ++m)
#pragma unroll
                    for (int n = 0; n < 2; ++n) acc[a][b][m][n] = (f32x4){0.f, 0.f, 0.f, 0.f};
        cur = nxt; cA = nA; cB = nB; ++ui;
    }
    PG8_WAIT_V(0);
    if (wr == 0) PG8_BAR;
    PG8_BAR;
#undef PG8_SA
#undef PG8_SB
#undef PG8_STAGE
#undef PG8_LDA
#undef PG8_LDB
#undef PG8_MMA
#undef PG8_WAIT_V
#undef PG8_WAIT_L
#undef PG8_BAR
#undef PG8_SCHED
}

struct EpiIn {
    static constexpr bool PERM = true;
    bf16_t* O; const float* rowss;
    __device__ __forceinline__ void operator()(const f32x4 (&acc)[2][2][4][2], const Unit& u, int wr, int wc, int fr, int fq) const {
        const int row0 = u.pm * BM + wr * 64 + fr, col0 = u.pn * BM + wc * 32 + 8 * fq;
#pragma unroll
        for (int ai = 0; ai < 2; ++ai)
#pragma unroll
            for (int m = 0; m < 4; ++m) { const int r = row0 + ai * HALF + m * 16; const float inv = rsqrtf(rowss[r] * (1.0f / DM) + EPS);
                bf16_t* rowp = O + (size_t)r * DE2 + col0;
#pragma unroll
                for (int bj = 0; bj < 2; ++bj) { const f32x4 v0 = acc[ai][bj][m][0] * inv, v1 = acc[ai][bj][m][1] * inv;
                    u32x4 w; w.x = cvt_pk_bf16(v0[0], v0[1]); w.y = cvt_pk_bf16(v0[2], v0[3]); w.z = cvt_pk_bf16(v1[0], v1[1]); w.w = cvt_pk_bf16(v1[2], v1[3]);
                    *(u32x4*)(rowp + bj * HALF) = w; } }
    }
};
struct EpiPool {
    static constexpr bool PERM = true;
    bf16_t* O; const bf16_t* Z; const float* scale;
    __device__ __forceinline__ void operator()(const f32x4 (&acc)[2][2][4][2], const Unit& u, int wr, int wc, int fr, int fq) const {
        const int row0 = u.pm * BM + wr * 64 + fr, col0 = u.pn * BM + wc * 32 + 8 * fq;
#pragma unroll
        for (int bj = 0; bj < 2; ++bj) { const int c = col0 + bj * HALF; const f32x4 s0 = *(const f32x4*)(scale + c), s1 = *(const f32x4*)(scale + c + 4);
#pragma unroll
            for (int ai = 0; ai < 2; ++ai)
#pragma unroll
                for (int m = 0; m < 4; ++m) { const int r = row0 + ai * HALF + m * 16;
                    const u32x4 zw = *(const u32x4*)(Z + (size_t)r * DE2 + c);
                    const f32x4 a0 = acc[ai][bj][m][0] * s0, a1 = acc[ai][bj][m][1] * s1;
                    u32x4 w;
                    w.x = cvt_pk_bf16(a0[0] * silu_f(bf_lo(zw.x)), a0[1] * silu_f(bf_hi(zw.x)));
                    w.y = cvt_pk_bf16(a0[2] * silu_f(bf_lo(zw.y)), a0[3] * silu_f(bf_hi(zw.y)));
                    w.z = cvt_pk_bf16(a1[0] * silu_f(bf_lo(zw.z)), a1[1] * silu_f(bf_hi(zw.z)));
                    w.w = cvt_pk_bf16(a1[2] * silu_f(bf_lo(zw.w)), a1[3] * silu_f(bf_hi(zw.w)));
                    *(u32x4*)(O + (size_t)r * DE + c) = w; } }
    }
};
struct EpiGlu {
    static constexpr bool PERM = true;
    bf16_t* O; const bf16_t* Z; const bf16_t* Gm; const float* bias;
    __device__ __forceinline__ void operator()(const f32x4 (&acc)[2][2][4][2], const Unit& u, int wr, int wc, int fr, int fq) const {
        const int row0 = u.pm * BM + wr * 64 + fr, col0 = u.pn * BM + wc * 32 + 8 * fq;
#pragma unroll
        for (int bj = 0; bj < 2; ++bj) { const int c = col0 + bj * HALF; const f32x4 b0 = *(const f32x4*)(bias + c), b1 = *(const f32x4*)(bias + c + 4);
#pragma unroll
            for (int ai = 0; ai < 2; ++ai)
#pragma unroll
                for (int m = 0; m < 4; ++m) { const int r = row0 + ai * HALF + m * 16;
                    const u32x4 zw = *(const u32x4*)(Z + (size_t)r * DE2 + c);
                    const u32x4 gw = *(const u32x4*)(Gm + (size_t)r * DE + c);
                    const f32x4 a0 = acc[ai][bj][m][0] + b0, a1 = acc[ai][bj][m][1] + b1;
                    u32x4 w;
                    w.x = cvt_pk_bf16(bf_lo(gw.x) * sigmoid_f(a0[0]) * silu_f(bf_lo(zw.x)), bf_hi(gw.x) * sigmoid_f(a0[1]) * silu_f(bf_hi(zw.x)));
                    w.y = cvt_pk_bf16(bf_lo(gw.y) * sigmoid_f(a0[2]) * silu_f(bf_lo(zw.y)), bf_hi(gw.y) * sigmoid_f(a0[3]) * silu_f(bf_hi(zw.y)));
                    w.z = cvt_pk_bf16(bf_lo(gw.z) * sigmoid_f(a1[0]) * silu_f(bf_lo(zw.z)), bf_hi(gw.z) * sigmoid_f(a1[1]) * silu_f(bf_hi(zw.z)));
                    w.w = cvt_pk_bf16(bf_lo(gw.w) * sigmoid_f(a1[2]) * silu_f(bf_lo(zw.w)), bf_hi(gw.w) * sigmoid_f(a1[3]) * silu_f(bf_hi(zw.w)));
                    *(u32x4*)(O + (size_t)r * DE + c) = w; } }
    }
};
struct EpiOut {
    static constexpr bool PERM = false;
    float* X; bf16_t* H; const float* gnext; float* rowss_next;
    __device__ __forceinline__ void operator()(const f32x4 (&acc)[2][2][4][2], const Unit& u, int wr, int wc, int fr, int fq) const {
        const int row0 = u.pm * BM + wr * 64 + fr, col0 = u.pn * BM + wc * 32 + 4 * fq;
#pragma unroll
        for (int ai = 0; ai < 2; ++ai)
#pragma unroll
            for (int m = 0; m < 4; ++m) { const int r = row0 + ai * HALF + m * 16; float ss = 0.f;
#pragma unroll
                for (int bj = 0; bj < 2; ++bj)
#pragma unroll
                    for (int n = 0; n < 2; ++n) { const int c = col0 + bj * HALF + n * 16; float* xp = X + (size_t)r * DM + c;
                        const f32x4 xv = *(const f32x4*)xp + acc[ai][bj][m][n]; *(f32x4*)xp = xv;
                        ss += (xv[0] * xv[0] + xv[1] * xv[1]) + (xv[2] * xv[2] + xv[3] * xv[3]);
                        if (H) { const f32x4 gv = *(const f32x4*)(gnext + c); const f32x4 hv = xv * gv; u32x2 w; w.x = cvt_pk_bf16(hv[0], hv[1]); w.y = cvt_pk_bf16(hv[2], hv[3]);
                            *(u32x2*)(H + (size_t)r * DM + c) = w; } }
                ss += __shfl_xor(ss, 16); ss += __shfl_xor(ss, 32);
                if (fq == 0) atomicAdd(rowss_next + r, ss); }
    }
};
}

__device__ void transpose_cvt(const float* __restrict__ src, bf16_t* __restrict__ dst, int K, int N, float* tile) {
    const int tid = fresh_tid(), tn = N / 64, ntile = (K / 64) * tn;
    for (int t = blockIdx.x; t < ntile; t += gridDim.x) {
        const int k0 = (t / tn) * 64, n0 = (t % tn) * 64;
#pragma unroll
        for (int i = 0; i < 2; ++i) { const int f = tid + i * 512, r = f >> 4, c4 = (f & 15) * 4;
            const float4 v = *(const float4*)(src + (size_t)(k0 + r) * N + n0 + c4);
            float* tp = tile + r * 65 + c4; tp[0] = v.x; tp[1] = v.y; tp[2] = v.z; tp[3] = v.w; }
        __syncthreads();
        { const int n = tid >> 3, k8 = (tid & 7) * 8; const float* tp = tile + k8 * 65 + n;
          u32x4 w; w.x = cvt_pk_bf16(tp[0], tp[65]); w.y = cvt_pk_bf16(tp[130], tp[195]); w.z = cvt_pk_bf16(tp[260], tp[325]); w.w = cvt_pk_bf16(tp[390], tp[455]);
          *(u32x4*)(dst + (size_t)(n0 + n) * K + k0 + k8) = w; }
        __syncthreads();
    }
}

__device__ void phase_prep(float* ldsf) {
    const ParamsPtr pq = params_ptr(); Params p;
#pragma unroll
    for (int i = 0; i < 19; ++i) p.in[i] = pq->in[i];
    p.out = pq->out; p.ws = pq->ws; p.ph_lo = 0; p.ph_hi = 0;
    const int tid = fresh_tid(), lane = tid & 63, wave = tid >> 6;
    const float* x = p.in[0]; const float* g0 = p.in[1];
    bf16_t* hbf = (bf16_t*)(p.ws + WS_HBF); float* rowss = (float*)(p.ws + WS_ROWSS);
    for (int row = blockIdx.x * 8 + wave; row < M_TOK; row += gridDim.x * 8) {
        const float4* xr = (const float4*)(x + (size_t)row * DM); float4* orow = (float4*)(p.out + (size_t)row * DM);
        float ss = 0.f;
#pragma unroll
        for (int i = 0; i < 8; ++i) { const int idx = i * 64 + lane; const float4 v = xr[idx]; orow[idx] = v;
            ss += (v.x * v.x + v.y * v.y) + (v.z * v.z + v.w * v.w);
            const float4 g = ((const float4*)g0)[idx];
            u32x2 w; w.x = cvt_pk_bf16(v.x * g.x, v.y * g.y); w.y = cvt_pk_bf16(v.z * g.z, v.w * g.w);
            *(u32x2*)(hbf + (size_t)row * DM + idx * 4) = w; }
#pragma unroll
        for (int o = 32; o >= 1; o >>= 1) ss += __shfl_xor(ss, o);
        if (lane == 0) rowss[row] = ss;
    }
    for (int i = blockIdx.x * NTHREADS + tid; i < 4 * M_TOK; i += gridDim.x * NTHREADS) rowss[M_TOK + i] = 0.f;
    for (int j = 0; j < 2; ++j) {
        bf16_t* wp = (bf16_t*)(p.ws + WS_W + j * W_POOL_SZ);
        transpose_cvt(p.in[3] + (size_t)j * DM * DE2, wp + W_POOL_IN / 2, DM, DE2, ldsf);
        for (int g = 0; g < 4; ++g) transpose_cvt(p.in[4] + ((size_t)j * 4 + g) * 1024 * 1024, wp + W_POOL_GRP / 2 + (size_t)g * 1024 * 1024, 1024, 1024, ldsf);
        transpose_cvt(p.in[6] + (size_t)j * DE * DM, wp + W_POOL_OUT / 2, DE, DM, ldsf);
        bf16_t* ws_ = (bf16_t*)(p.ws + WS_WSSM + j * W_SSM_SZ);
        transpose_cvt(p.in[7] + (size_t)j * DM * DE2, ws_ + W_SSM_IN / 2, DM, DE2, ldsf);
        transpose_cvt(p.in[16] + (size_t)j * DE * DE, ws_ + W_SSM_GLU / 2, DE, DE, ldsf);
        transpose_cvt(p.in[18] + (size_t)j * DE * DM, ws_ + W_SSM_OUT / 2, DE, DM, ldsf);
    }
}

__device__ void phase_pool() {
    const ParamsPtr p_ = params_ptr(); struct { unsigned char* ws; } p{p_->ws};
    const bf16_t* uz = (const bf16_t*)(p.ws + WS_UZ); bf16_t* pg = (bf16_t*)(p.ws + WS_PG);
    for (int idx = blockIdx.x * NTHREADS + fresh_tid(); idx < M_TOK * (DE / 8); idx += gridDim.x * NTHREADS) {
        const int row = idx / (DE / 8), c8 = idx % (DE / 8), col = c8 * 8, g = col >> 10, w = 2 << g, tl = row & (SEQ - 1);
        const int cnt = (tl + 1 < w) ? tl + 1 : w;
        float s[8];
#pragma unroll
        for (int i = 0; i < 8; ++i) s[i] = 0.f;
        u32x4 cur = (u32x4){0u, 0u, 0u, 0u};
        for (int k = 0; k < cnt; ++k) { const u32x4 v = *(const u32x4*)(uz + (size_t)(row - k) * DE2 + col); if (k == 0) cur = v;
            s[0] += bf_lo(v.x); s[1] += bf_hi(v.x); s[2] += bf_lo(v.y); s[3] += bf_hi(v.y); s[4] += bf_lo(v.z); s[5] += bf_hi(v.z); s[6] += bf_lo(v.w); s[7] += bf_hi(v.w); }
        const float ic = 1.0f / (float)cnt;
        u32x4 o;
        o.x = cvt_pk_bf16(s[0] * ic - bf_lo(cur.x), s[1] * ic - bf_hi(cur.x)); o.y = cvt_pk_bf16(s[2] * ic - bf_lo(cur.y), s[3] * ic - bf_hi(cur.y));
        o.z = cvt_pk_bf16(s[4] * ic - bf_lo(cur.z), s[5] * ic - bf_hi(cur.z)); o.w = cvt_pk_bf16(s[6] * ic - bf_lo(cur.w), s[7] * ic - bf_hi(cur.w));
        *(u32x4*)(pg + (size_t)row * DE + col) = o;
    }
}

__device__ void phase_ssm(int j, float* ldsf) {
    const ParamsPtr pq = params_ptr(); Params p;
#pragma unroll
    for (int i = 0; i < 19; ++i) p.in[i] = pq->in[i];
    p.out = pq->out; p.ws = pq->ws; p.ph_lo = 0; p.ph_hi = 0;
    const int tid = fresh_tid(), lane = tid & 63, wave = tid >> 6;
    const bf16_t* uz = (const bf16_t*)(p.ws + WS_UZ); bf16_t* gout = (bf16_t*)(p.ws + WS_PG);
    f32x2* APOW = (f32x2*)ldsf;
    f32x2* BBAR = APOW + 64 * 17;
    f32x2* CC = BBAR + 64 * 16;
    float* KT = (float*)(CC + 16 * 64);
    for (int g = blockIdx.x; g < NG; g += gridDim.x) {
        f32x2* sbuf = (f32x2*)(p.ws + WS_GATED) + (size_t)g * (2 * NCH * NS);
        __syncthreads();
        if (tid < 64) { const int n = tid;
            const float are = p.in[8][((size_t)j * NG + g) * NS + n], aim = p.in[9][((size_t)j * NG + g) * NS + n];
            const float dt = expf(p.in[10][(size_t)j * NG + g]);
            for (int k = 0; k <= 16; ++k) { const float mg = expf(are * dt * (float)k); float sn, cs; sincosf(aim * dt * (float)k, &sn, &cs); APOW[n * 17 + k] = (f32x2){mg * cs, mg * sn}; }
            const float mag = expf(are * dt); float sn, cs; sincosf(aim * dt, &sn, &cs);
            const float abr = mag * cs, abi = mag * sn, den = are * are + aim * aim, nr = abr - 1.0f;
            const float fr = (nr * are + abi * aim) / den, fi = (abi * are - nr * aim) / den;
            const float* bre = p.in[11] + (((size_t)j * NG + g) * NS + n) * NP; const float* bim = p.in[12] + (((size_t)j * NG + g) * NS + n) * NP;
            for (int q = 0; q < NP; ++q) BBAR[n * 16 + q] = (f32x2){fr * bre[q] - fi * bim[q], fr * bim[q] + fi * bre[q]};
        }
        for (int i = tid; i < NP * NS; i += NTHREADS) { const size_t o = ((size_t)j * NG + g) * NP * NS + i; CC[i] = (f32x2){p.in[13][o], p.in[14][o]}; }
        __syncthreads();
        for (int i = tid; i < 16 * 16 * 16; i += NTHREADS) { const int tau = i >> 8, pp = (i >> 4) & 15, q = i & 15; float s = 0.f;
            for (int n = 0; n < NS; ++n) { const f32x2 a = APOW[n * 17 + tau], b = BBAR[n * 16 + q], c = CC[pp * 64 + n];
                const float xr = a.x * b.x - a.y * b.y, xi = a.x * b.y + a.y * b.x; s += c.x * xr - c.y * xi; }
            KT[i] = s; }
        __syncthreads();
        { const f32x2 A1 = APOW[lane * 17 + 1]; f32x2 bbr[16];
#pragma unroll
          for (int q = 0; q < 16; ++q) bbr[q] = BBAR[lane * 16 + q];
          for (int pair = wave; pair < 2 * NCH; pair += 8) { const int b = pair / NCH, c = pair % NCH; float hr = 0.f, hi = 0.f;
            for (int jj = 0; jj < TCH; ++jj) { const bf16_t* ur = uz + (size_t)(b * SEQ + c * TCH + jj) * DE2 + g * NP;
                const u32x4 w0 = *(const u32x4*)ur, w1 = *(const u32x4*)(ur + 8);
                const float uu[16] = {bf_lo(w0.x), bf_hi(w0.x), bf_lo(w0.y), bf_hi(w0.y), bf_lo(w0.z), bf_hi(w0.z), bf_lo(w0.w), bf_hi(w0.w),
                                      bf_lo(w1.x), bf_hi(w1.x), bf_lo(w1.y), bf_hi(w1.y), bf_lo(w1.z), bf_hi(w1.z), bf_lo(w1.w), bf_hi(w1.w)};
                float br = 0.f, bi = 0.f;
#pragma unroll
                for (int q = 0; q < 16; ++q) { br += bbr[q].x * uu[q]; bi += bbr[q].y * uu[q]; }
                const float nr = A1.x * hr - A1.y * hi + br, ni = A1.x * hi + A1.y * hr + bi; hr = nr; hi = ni; }
            sbuf[(size_t)(b * NCH + c) * NS + lane] = (f32x2){hr, hi}; } }
        __threadfence(); __syncthreads();
        if (tid < 128) { const int b = tid >> 6, n = tid & 63; const f32x2 A16 = APOW[n * 17 + 16]; float hr = 0.f, hi = 0.f;
            for (int c = 0; c < NCH; ++c) { f32x2* sp = sbuf + (size_t)(b * NCH + c) * NS + n; const f32x2 s = *sp; *sp = (f32x2){hr, hi};
                const float nr = A16.x * hr - A16.y * hi + s.x, ni = A16.x * hi + A16.y * hr + s.y; hr = nr; hi = ni; } }
        __threadfence(); __syncthreads();
        const float* dsk = p.in[15] + (size_t)j * DE + g * NP;
        for (int idx = tid; idx < 2 * SEQ * NP; idx += NTHREADS) { const int pp = idx & 15, t = (idx >> 4) & (SEQ - 1), b = idx >> 16, c = t >> 4, jj = t & 15;
            float y = 0.f;
            for (int jp = 0; jp <= jj; ++jp) { const bf16_t* ur = uz + (size_t)(b * SEQ + c * TCH + jp) * DE2 + g * NP;
                const u32x4 w0 = *(const u32x4*)ur, w1 = *(const u32x4*)(ur + 8); const float* kt = KT + ((jj - jp) * 16 + pp) * 16;
                y += kt[0] * bf_lo(w0.x) + kt[1] * bf_hi(w0.x) + kt[2] * bf_lo(w0.y) + kt[3] * bf_hi(w0.y) + kt[4] * bf_lo(w0.z) + kt[5] * bf_hi(w0.z) + kt[6] * bf_lo(w0.w) + kt[7] * bf_hi(w0.w)
                   + kt[8] * bf_lo(w1.x) + kt[9] * bf_hi(w1.x) + kt[10] * bf_lo(w1.y) + kt[11] * bf_hi(w1.y) + kt[12] * bf_lo(w1.z) + kt[13] * bf_hi(w1.z) + kt[14] * bf_lo(w1.w) + kt[15] * bf_hi(w1.w); }
            const f32x2* hin = sbuf + (size_t)(b * NCH + c) * NS;
            for (int n = 0; n < NS; ++n) { const f32x2 cc = CC[pp * 64 + n], ap = APOW[n * 17 + jj + 1], h = hin[n];
                const float car = cc.x * ap.x - cc.y * ap.y, cai = cc.x * ap.y + cc.y * ap.x; y += car * h.x - cai * h.y; }
            const float ut = bf2f(uz[(size_t)(b * SEQ + t) * DE2 + g * NP + pp]);
            y += dsk[pp] * ut;
            const float gv = gelu_tanh_f(y);
            gout[(size_t)(b * SEQ + t) * DE + g * NP + pp] = (bf16_t)(cvt_pk_bf16(gv, 0.f) & 0xffffu); }
    }
}

__device__ void phase_final() {
    const ParamsPtr pq = params_ptr(); struct { const float* in[3]; float* out; unsigned char* ws; } p{{pq->in[0], pq->in[1], pq->in[2]}, pq->out, pq->ws};
    const float* rowss = (const float*)(p.ws + WS_ROWSS) + 4 * M_TOK; const float* gf = p.in[2];
    const int tid = fresh_tid(), lane = tid & 63, wave = tid >> 6;
    for (int row = blockIdx.x * 8 + wave; row < M_TOK; row += gridDim.x * 8) {
        const float inv = rsqrtf(rowss[row] * (1.0f / DM) + EPS); float4* xr = (float4*)(p.out + (size_t)row * DM);
#pragma unroll
        for (int i = 0; i < 8; ++i) { const int idx = i * 64 + lane; float4 v = xr[idx]; const float4 g = ((const float4*)gf)[idx];
            v.x *= inv * g.x; v.y *= inv * g.y; v.z *= inv * g.z; v.w *= inv * g.w; xr[idx] = v; }
    }
}

__global__ void __launch_bounds__(NTHREADS, 2) fwd_megakernel(Params p_unused) {
    extern __shared__ __attribute__((aligned(16))) unsigned char lds[];
    LAS unsigned char* ldsl = (LAS unsigned char*)lds;
    float* ldsf = (float*)lds;
    cg::grid_group grid = cg::this_grid();
    const int lo = params_ptr()->ph_lo, hi = params_ptr()->ph_hi;
    const int G = gridDim.x, bx = blockIdx.x;
    int ph = 0;
#define SEAM() do { if (lo <= ph && ph + 1 < hi) grid.sync(); ++ph; } while (0)
#define RUN (lo <= ph && ph < hi)
#define WSP(off) ((bf16_t*)(q->ws + (off)))
    if (RUN) phase_prep(ldsf);
    SEAM();
#pragma unroll 1
    for (int l = 0; l < 4; ++l) {
        const int j = l >> 1; const bool ssm = (l & 1);
        const size_t wofs = ssm ? WS_WSSM + j * W_SSM_SZ : WS_W + j * W_POOL_SZ;
        if (RUN) { const ParamsPtr q = params_ptr(); pg8::Gemm g{WSP(WS_HBF), WSP(wofs), M_TOK, DE2, DM, DM, 0}; pg8::StaticOrder S; S.init(M_TOK, DE2, G, bx);
            pg8::EpiIn E{WSP(WS_UZ), (const float*)(q->ws + WS_ROWSS) + l * M_TOK}; pg8::gemm_phase<pg8::EpiIn>(ldsl, g, S, E); }
        SEAM();
        if (!ssm) {
            if (RUN) phase_pool();
            SEAM();
            if (RUN) { const ParamsPtr q = params_ptr(); pg8::Gemm g{WSP(WS_PG), WSP(wofs + W_POOL_GRP), M_TOK, DE, 1024, DE, 1}; pg8::StaticOrder S; S.init(M_TOK, DE, G, bx);
                pg8::EpiPool E{WSP(WS_GATED), WSP(WS_UZ) + DE, q->in[5] + (size_t)j * DE}; pg8::gemm_phase<pg8::EpiPool>(ldsl, g, S, E); }
            SEAM();
        } else {
            if (RUN) phase_ssm(j, ldsf);
            SEAM();
            if (RUN) { const ParamsPtr q = params_ptr(); pg8::Gemm g{WSP(WS_PG), WSP(wofs + W_SSM_GLU), M_TOK, DE, DE, DE, 0}; pg8::StaticOrder S; S.init(M_TOK, DE, G, bx);
                pg8::EpiGlu E{WSP(WS_GATED), WSP(WS_UZ) + DE, WSP(WS_PG), q->in[17] + (size_t)j * DE}; pg8::gemm_phase<pg8::EpiGlu>(ldsl, g, S, E); }
            SEAM();
        }
        if (RUN) { const ParamsPtr q = params_ptr(); pg8::Gemm g{WSP(WS_GATED), WSP(wofs + (ssm ? W_SSM_OUT : W_POOL_OUT)), M_TOK, DM, DE, DE, 0}; pg8::StaticOrder S; S.init(M_TOK, DM, G, bx);
            pg8::EpiOut E{q->out, (l < 3) ? WSP(WS_HBF) : nullptr, q->in[1] + (size_t)(l < 3 ? l + 1 : 0) * DM, (float*)(q->ws + WS_ROWSS) + (l + 1) * M_TOK}; pg8::gemm_phase<pg8::EpiOut>(ldsl, g, S, E); }
        SEAM();
    }
    if (RUN) phase_final();
#undef SEAM
#undef RUN
#undef WSP
}
constexpr int N_PHASES = 18;

extern "C" void kernel_launch(void* const* d_in, const int* in_sizes, int n_in, void* d_out, int out_size, void* d_ws, size_t ws_size, hipStream_t stream) {
    static int grid = 0;
    if (grid == 0) {
        if (n_in != 19 || out_size != M_TOK * DM || ws_size < WS_END) { fprintf(stderr, "kernel_launch: unexpected shapes (n_in %d out %d ws %zu need %zu)\n", n_in, out_size, ws_size, (size_t)WS_END); grid = -1; return; }
        int dev = 0, cus = 0, per_cu = 0;
        hipGetDevice(&dev); hipDeviceGetAttribute(&cus, hipDeviceAttributeMultiprocessorCount, dev);
        if (hipFuncSetAttribute((const void*)fwd_megakernel, hipFuncAttributeMaxDynamicSharedMemorySize, LDS_BYTES) != hipSuccess) { fprintf(stderr, "kernel_launch: hipFuncSetAttribute failed\n"); grid = -1; return; }
        hipOccupancyMaxActiveBlocksPerMultiprocessor(&per_cu, (const void*)fwd_megakernel, NTHREADS, LDS_BYTES);
        if (per_cu < 1) { fprintf(stderr, "kernel_launch: occupancy query says %d blocks per CU\n", per_cu); per_cu = 1; }
        (void)hipGetLastError();
        grid = cus;
    }
    if (grid < 0) return;
    Params p{};
    for (int i = 0; i < 19; ++i) p.in[i] = (const float*)d_in[i];
    p.out = (float*)d_out; p.ws = (unsigned char*)d_ws;
#if ONE_LAUNCH
    p.ph_lo = 0; p.ph_hi = N_PHASES;
    void* args[] = {&p};
    hipError_t e = hipLaunchCooperativeKernel((const void*)fwd_megakernel, dim3(grid), dim3(NTHREADS), args, LDS_BYTES, stream);
    if (e != hipSuccess) fprintf(stderr, "cooperative launch failed: %s (grid %d)\n", hipGetErrorString(e), grid);
#else
    for (int ph = 0; ph < N_PHASES; ++ph) { p.ph_lo = ph; p.ph_hi = ph + 1;
        hipLaunchKernelGGL(fwd_megakernel, dim3(grid), dim3(NTHREADS), LDS_BYTES, stream, p); }
#endif
}
```

```cpp
#include <hip/hip_runtime.h>
#include <hip/hip_cooperative_groups.h>
#include <cstdio>
namespace cg = cooperative_groups;

#ifndef ONE_LAUNCH
#define ONE_LAUNCH 1
#endif

#define LAS __attribute__((address_space(3)))
typedef unsigned short bf16_t;
typedef short bf16x8 __attribute__((ext_vector_type(8)));
typedef float f32x4 __attribute__((ext_vector_type(4)));
typedef float f32x2 __attribute__((ext_vector_type(2)));
typedef unsigned u32x4 __attribute__((ext_vector_type(4)));
typedef unsigned u32x2 __attribute__((ext_vector_type(2)));

constexpr int M_TOK = 8192, SEQ = 4096, DM = 2048, DE = 4096, DE2 = 8192;
constexpr int NG = 256, NS = 64, NP = 16, TCH = 16, NCH = SEQ / TCH;
constexpr float EPS = 1e-6f;
constexpr int NTHREADS = 512;
constexpr int GSTR = M_TOK * 16 + 2176;
constexpr int HSTR = 2 * (SEQ / 16) * 128 + 1088;
constexpr int LDS_BYTES = 163840;
constexpr int XB_LDS_OFF = LDS_BYTES - 64;

constexpr size_t MiB = 1024 * 1024;
constexpr size_t WS_HBF = 0;
constexpr size_t WS_UZ = WS_HBF + 34 * MiB;
constexpr size_t WS_PG = WS_UZ + 128 * MiB;
constexpr size_t WS_GATED = WS_PG + 66 * MiB;
constexpr size_t WS_W = WS_GATED + 66 * MiB;
constexpr size_t W_POOL_IN = 0, W_POOL_GRP = 32 * MiB, W_POOL_OUT = 40 * MiB, W_POOL_SZ = 56 * MiB;
constexpr size_t W_SSM_IN = 0, W_SSM_GLU = 32 * MiB, W_SSM_OUT = 64 * MiB, W_SSM_SZ = 80 * MiB;
constexpr size_t WS_WSSM = WS_W + 2 * W_POOL_SZ;
constexpr size_t WS_ROWSS = WS_WSSM + 2 * W_SSM_SZ;
constexpr size_t WS_BAR = WS_ROWSS + 512 * 1024;
constexpr size_t WS_PCNT = WS_BAR + 16 * 1024;
constexpr size_t WS_END = WS_ROWSS + 1 * MiB;

struct Params {
    const float* in[19];
    float* out;
    unsigned char* ws;
    int ph_lo, ph_hi;
};

typedef const __attribute__((address_space(4))) Params* ParamsPtr;
__device__ __forceinline__ ParamsPtr params_ptr() { ParamsPtr q = (ParamsPtr)__builtin_amdgcn_kernarg_segment_ptr(); asm volatile("" : "+s"(q)); return q; }
__device__ __forceinline__ int fresh_tid() { int t = threadIdx.x; asm volatile("" : "+v"(t)); return t; }

__device__ __forceinline__ unsigned cvt_pk_bf16(float lo, float hi) { unsigned r; asm volatile("v_cvt_pk_bf16_f32 %0, %1, %2" : "=v"(r) : "v"(lo), "v"(hi)); return r; }
__device__ __forceinline__ float bf_lo(unsigned w) { return __uint_as_float(w << 16); }
__device__ __forceinline__ float bf_hi(unsigned w) { return __uint_as_float(w & 0xffff0000u); }
__device__ __forceinline__ float bf2f(bf16_t b) { return __uint_as_float(((unsigned)b) << 16); }
__device__ __forceinline__ float fast_rcp(float x) { return __builtin_amdgcn_rcpf(x); }
__device__ __forceinline__ float silu_f(float z) { return z * fast_rcp(1.0f + __builtin_amdgcn_exp2f(z * -1.44269504f)); }
__device__ __forceinline__ float sigmoid_f(float z) { return fast_rcp(1.0f + __expf(-z)); }
__device__ __forceinline__ float gelu_tanh_f(float y) {
    const float t = __builtin_amdgcn_exp2f(y * __builtin_fmaf(-0.10294324f, y * y, -2.3022082f));
    return y * fast_rcp(1.0f + t);
}
__device__ __forceinline__ float glu_gate_f(float g, float v, float z) {
    const float ev = __builtin_amdgcn_exp2f(v * -1.44269504f), ez = __builtin_amdgcn_exp2f(z * -1.44269504f);
    return g * z * fast_rcp((1.0f + ev) * (1.0f + ez));
}

namespace pg8 {
constexpr int BM = 256, BK = 64, HALF = 128, HTB = HALF * BK * 2, STAGE_BYTES = 8 * HTB, NXCD = 8, WGM = 8;
__host__ __device__ __forceinline__ int lds_byte(int r, int c) { const int st = (r >> 4) * 2 + (c >> 5), rr = r & 15, cc = c & 31, ob = rr * 64 + cc * 2; return st * 1024 + (ob ^ (((ob >> 9) & 1) << 5)); }
__host__ __device__ __forceinline__ void stage_rc(int b, int& R, int& C) { const int st = b / 1024, sb = b % 1024, swz = sb ^ (((sb >> 9) & 1) << 5); R = (st >> 1) * 16 + swz / 64; C = (st & 1) * 32 + (swz % 64) / 2; }
__host__ __device__ __forceinline__ int perm32(int rho) { const int n = rho >> 4, i = rho & 15; return 8 * (i >> 2) + 4 * n + (i & 3); }

struct Unit { int pm, pn; };
struct Gemm { const bf16_t* A; const bf16_t* Bt; int M, N, K; unsigned a_row, a_c16, a_kt; int grouped; };

struct StaticOrder {
    int nM, nN, nwg, G, c;
    __device__ void init(int M, int N, int G_, int c_) { nM = M / BM; nN = N / BM; nwg = nM * nN; G = G_; c = c_; }
    __device__ bool next(int i, Unit& u) const {
        const long L = (long)i * G + c; if (L >= nwg) return false;
        int wgid = (int)L; { const int q = nwg / NXCD, r = nwg % NXCD, xcd = wgid % NXCD, off = wgid / NXCD; wgid = (xcd < r ? xcd * (q + 1) : r * (q + 1) + (xcd - r) * q) + off; }
        const int nig = WGM * nN, gid = wgid / nig, fm = gid * WGM, gsz = (nM - fm) < WGM ? (nM - fm) : WGM;
        u.pm = fm + ((wgid % nig) % gsz); u.pn = (wgid % nig) / gsz; return true;
    }
};

template <class Epi>
__device__ __forceinline__ void gemm_phase(LAS unsigned char* lds, const Gemm g, const StaticOrder& S, const Epi& E) {
    const int tid = fresh_tid(), wid = __builtin_amdgcn_readfirstlane(tid >> 6), lane = tid & 63, wr = wid >> 2, wc = wid & 3, fr = lane & 15, fq = lane >> 4;
    const int K = g.K, nt = K / BK;
    unsigned voffA[2], voffB[2];
#pragma unroll
    for (int i = 0; i < 2; ++i) { int R, C; stage_rc(tid * 16 + i * 8192, R, C); const int Rb = Epi::PERM ? ((R & ~31) + perm32(R & 31)) : R;
        voffA[i] = (unsigned)R * g.a_row + (unsigned)(C >> 4) * g.a_c16 + (unsigned)(C & 15) * 2u; voffB[i] = (unsigned)(Rb * K + C) * 2u; }
    const size_t kstep = (size_t)(BK * 2), kstepA = (size_t)g.a_kt;
    const size_t hstepA = (size_t)HALF * g.a_row, hstepB = (size_t)HALF * K * 2;
    const size_t tstepA = 2 * hstepA, tstepB = 2 * hstepB;
    const size_t gstepA = g.grouped ? (size_t)K * 2 : 0;
    const unsigned ldsw = (unsigned)wid * 1024u;
    const int aoff = lds_byte(wr * 64 + fr, fq * 8), boff = lds_byte(wc * 32 + fr, fq * 8);
#define PG8_SA(b, h) (((b) * 2 + (h)) * HTB)
#define PG8_SB(b, h) ((4 + (b) * 2 + (h)) * HTB)
#define PG8_STAGE(bufoff, gbase, voff) do { _Pragma("unroll") for (int _i = 0; _i < 2; ++_i) \
        __builtin_amdgcn_global_load_lds((const unsigned*)((const char*)(gbase) + (voff)[_i]), (LAS unsigned*)(lds + (bufoff) + ldsw + _i * 8192), 16, 0, 0); } while (0)
#define PG8_LDA(dst, b, h) do { _Pragma("unroll") for (int m = 0; m < 4; ++m) _Pragma("unroll") for (int k = 0; k < 2; ++k) dst[m][k] = *(const LAS bf16x8*)(lds + PG8_SA(b, h) + aoff + m * 2048 + k * 1024); } while (0)
#define PG8_LDB(dst, b, h) do { _Pragma("unroll") for (int n = 0; n < 2; ++n) _Pragma("unroll") for (int k = 0; k < 2; ++k) dst[n][k] = *(const LAS bf16x8*)(lds + PG8_SB(b, h) + boff + n * 2048 + k * 1024); } while (0)
#define PG8_MMA(ai, bj, At, Bt) do { __builtin_amdgcn_s_setprio(1); _Pragma("unroll") for (int m = 0; m < 4; ++m) _Pragma("unroll") for (int n = 0; n < 2; ++n) _Pragma("unroll") for (int k = 0; k < 2; ++k) \
        acc[ai][bj][m][n] = __builtin_amdgcn_mfma_f32_16x16x32_bf16(Bt[n][k], At[m][k], acc[ai][bj][m][n], 0, 0, 0); __builtin_amdgcn_s_setprio(0); } while (0)
#define PG8_WAIT_V(n) asm volatile("s_waitcnt vmcnt(" #n ")" ::: "memory")
#define PG8_WAIT_L(n) asm volatile("s_waitcnt lgkmcnt(" #n ")" ::: "memory")
#define PG8_BAR __builtin_amdgcn_s_barrier()
#define PG8_SCHED __builtin_amdgcn_sched_barrier(0)
    Unit cur, nxt; int ui = 0;
    if (!S.next(0, cur)) return;
    typename Epi::Pre pre = E.pre(cur, wr, fr);
    f32x4 acc[2][2][4][2];
#pragma unroll
    for (int a = 0; a < 2; ++a)
#pragma unroll
        for (int b = 0; b < 2; ++b)
#pragma unroll
            for (int m = 0; m < 4; ++m)
#pragma unroll
                for (int n = 0; n < 2; ++n) acc[a][b][m][n] = (f32x4){0.f, 0.f, 0.f, 0.f};
    bf16x8 At[4][2], B0[2][2], B1[2][2];
    const char* cA = (const char*)g.A + (size_t)cur.pm * tstepA + (size_t)(cur.pn >> 2) * gstepA; const char* cB = (const char*)g.Bt + (size_t)cur.pn * tstepB;
    PG8_STAGE(PG8_SB(0, 0), cB, voffB); PG8_STAGE(PG8_SA(0, 0), cA, voffA); PG8_STAGE(PG8_SB(0, 1), cB + hstepB, voffB); PG8_STAGE(PG8_SA(0, 1), cA + hstepA, voffA);
    if (wr == 1) PG8_BAR;
    PG8_WAIT_V(4); PG8_BAR;
    PG8_STAGE(PG8_SB(1, 0), cB + kstep, voffB); PG8_STAGE(PG8_SA(1, 0), cA + kstepA, voffA); PG8_STAGE(PG8_SB(1, 1), cB + hstepB + kstep, voffB);
    PG8_WAIT_V(6); PG8_BAR;
    for (;;) {
        const bool has_next = S.next(ui + 1, nxt);
        const char* nA = has_next ? (const char*)g.A + (size_t)nxt.pm * tstepA + (size_t)(nxt.pn >> 2) * gstepA : cA; const char* nB = has_next ? (const char*)g.Bt + (size_t)nxt.pn * tstepB : cB;
        for (int t = 0; t < nt; t += 2) {
            const bool last = (t == nt - 2);
            const char* a1 = cA + (size_t)(t + 1) * kstepA;
            const char* a2 = last ? nA : cA + (size_t)(t + 2) * kstepA; const char* b2 = last ? nB : cB + (size_t)(t + 2) * kstep;
            const char* a3 = a2 + kstepA; const char* b3 = b2 + kstep;
            PG8_LDB(B0, 0, 0); PG8_SCHED; PG8_LDA(At, 0, 0); PG8_STAGE(PG8_SA(1, 1), a1 + hstepA, voffA);
            PG8_WAIT_L(8); PG8_BAR; PG8_WAIT_L(0); PG8_MMA(0, 0, At, B0); PG8_BAR; PG8_SCHED;
            PG8_LDB(B1, 0, 1); PG8_STAGE(PG8_SB(0, 0), b2, voffB);
            PG8_BAR; PG8_WAIT_L(0); PG8_MMA(0, 1, At, B1); PG8_BAR;
            PG8_LDA(At, 0, 1); PG8_STAGE(PG8_SA(0, 0), a2, voffA);
            PG8_BAR; PG8_WAIT_L(0); PG8_MMA(1, 0, At, B0); PG8_BAR; PG8_SCHED;
            PG8_STAGE(PG8_SB(0, 1), b2 + hstepB, voffB);
            PG8_WAIT_V(6); PG8_BAR; PG8_MMA(1, 1, At, B1); PG8_BAR;
            PG8_LDB(B0, 1, 0); PG8_SCHED; PG8_LDA(At, 1, 0); PG8_STAGE(PG8_SA(0, 1), a2 + hstepA, voffA);
            PG8_WAIT_L(8); PG8_BAR; PG8_WAIT_L(0); PG8_MMA(0, 0, At, B0); PG8_BAR; PG8_SCHED;
            PG8_LDB(B1, 1, 1); PG8_STAGE(PG8_SB(1, 0), b3, voffB);
            PG8_BAR; PG8_WAIT_L(0); PG8_MMA(0, 1, At, B1); PG8_BAR;
            PG8_LDA(At, 1, 1); PG8_STAGE(PG8_SA(1, 0), a3, voffA);
            PG8_BAR; PG8_WAIT_L(0); PG8_MMA(1, 0, At, B0); PG8_BAR; PG8_SCHED;
            PG8_STAGE(PG8_SB(1, 1), b3 + hstepB, voffB);
            PG8_WAIT_V(6); PG8_BAR; PG8_MMA(1, 1, At, B1); PG8_BAR;
        }
        if constexpr (!Epi::AFTER_DRAIN) E(acc, cur, wr, wc, fr, fq, pre);
        if (!has_next) break;
#pragma unroll
        for (int a = 0; a < 2; ++a)
#pragma unroll
            for (int b = 0; b < 2; ++b)
#pragma unroll
                for (int m = 0; m < 4; ++m)
#pragma unroll
                    for (int n = 0; n < 2; ++n) acc[a][b][m][n] = (f32x4){0.f, 0.f, 0.f, 0.f};
        cur = nxt; cA = nA; cB = nB; ++ui;
        pre = E.pre(cur, wr, fr);
    }
    PG8_WAIT_V(0);
    if (wr == 0) PG8_BAR;
    PG8_BAR;
    if constexpr (Epi::AFTER_DRAIN) E.fused(acc, cur, wr, wc, fr, fq);
#undef PG8_SA
#undef PG8_SB
#undef PG8_STAGE
#undef PG8_LDA
#undef PG8_LDB
#undef PG8_MMA
#undef PG8_WAIT_V
#undef PG8_WAIT_L
#undef PG8_BAR
#undef PG8_SCHED
}

struct EpiIn {
    static constexpr bool AFTER_DRAIN = false;
    static constexpr bool PERM = true;
    bf16_t* O; const float* rowss; bf16_t* UG;
    struct Pre { float rs[8]; };
    __device__ __forceinline__ Pre pre(const Unit& u, int wr, int fr) const { Pre p; const int row0 = u.pm * BM + wr * 64 + fr;
#pragma unroll
        for (int g8 = 0; g8 < 8; ++g8) p.rs[g8] = rowss[row0 + (g8 >> 2) * HALF + (g8 & 3) * 16];
        return p; }
    __device__ __forceinline__ void operator()(const f32x4 (&acc)[2][2][4][2], const Unit& u, int wr, int wc, int fr, int fq, const Pre& pp) const {
        const int row0 = u.pm * BM + wr * 64 + fr, col0 = u.pn * BM + wc * 32 + 8 * fq;
        const bool gm = (UG != nullptr) && (u.pn < DE / BM);
        const float (&rs)[8] = pp.rs;
#pragma unroll
        for (int ai = 0; ai < 2; ++ai)
#pragma unroll
            for (int m = 0; m < 4; ++m) { const int r = row0 + ai * HALF + m * 16; const float inv = rsqrtf(rs[ai * 4 + m] * (1.0f / DM) + EPS);
#pragma unroll
                for (int bj = 0; bj < 2; ++bj) { const f32x4 v0 = acc[ai][bj][m][0] * inv, v1 = acc[ai][bj][m][1] * inv; const int c = col0 + bj * HALF;
                    u32x4 w; w.x = cvt_pk_bf16(v0[0], v0[1]); w.y = cvt_pk_bf16(v0[2], v0[3]); w.z = cvt_pk_bf16(v1[0], v1[1]); w.w = cvt_pk_bf16(v1[2], v1[3]);
                    bf16_t* dst = gm ? UG + (size_t)(c >> 4) * GSTR + r * 16 + (c & 15) : O + (size_t)r * DE2 + c;
                    *(u32x4*)dst = w; } }
    }
};
struct EpiPool {
    static constexpr bool AFTER_DRAIN = false;
    static constexpr bool PERM = true;
    bf16_t* O; const bf16_t* Z; const float* scale;
    struct Pre {};
    __device__ __forceinline__ Pre pre(const Unit&, int, int) const { return Pre{}; }
    __device__ __forceinline__ void operator()(const f32x4 (&acc)[2][2][4][2], const Unit& u, int wr, int wc, int fr, int fq, const Pre&) const {
        const int row0 = u.pm * BM + wr * 64 + fr, col0 = u.pn * BM + wc * 32 + 8 * fq;
        f32x4 sc[2][2];
#pragma unroll
        for (int bj = 0; bj < 2; ++bj) { sc[bj][0] = *(const f32x4*)(scale + col0 + bj * HALF); sc[bj][1] = *(const f32x4*)(scale + col0 + bj * HALF + 4); }
#pragma unroll
        for (int bj = 0; bj < 2; ++bj) { const int c = col0 + bj * HALF;
            u32x4 zv[8];
#pragma unroll
            for (int g8 = 0; g8 < 8; ++g8) zv[g8] = __builtin_nontemporal_load((const u32x4*)(Z + (size_t)(row0 + (g8 >> 2) * HALF + (g8 & 3) * 16) * DE2 + c));
#pragma unroll
            for (int ai = 0; ai < 2; ++ai)
#pragma unroll
                for (int m = 0; m < 4; ++m) { const int r = row0 + ai * HALF + m * 16;
                    const u32x4 zw = zv[ai * 4 + m];
                    const f32x4 a0 = acc[ai][bj][m][0] * sc[bj][0], a1 = acc[ai][bj][m][1] * sc[bj][1];
                    u32x4 w;
                    w.x = cvt_pk_bf16(a0[0] * silu_f(bf_lo(zw.x)), a0[1] * silu_f(bf_hi(zw.x)));
                    w.y = cvt_pk_bf16(a0[2] * silu_f(bf_lo(zw.y)), a0[3] * silu_f(bf_hi(zw.y)));
                    w.z = cvt_pk_bf16(a1[0] * silu_f(bf_lo(zw.z)), a1[1] * silu_f(bf_hi(zw.z)));
                    w.w = cvt_pk_bf16(a1[2] * silu_f(bf_lo(zw.w)), a1[3] * silu_f(bf_hi(zw.w)));
                    *(u32x4*)(O + (size_t)r * DE + c) = w; } }
    }
};
struct EpiGlu {
    static constexpr bool AFTER_DRAIN = false;
    static constexpr bool PERM = true;
    bf16_t* O; const bf16_t* Z; const bf16_t* Gm; const float* bias;
    struct Pre {};
    __device__ __forceinline__ Pre pre(const Unit&, int, int) const { return Pre{}; }
    __device__ __forceinline__ void operator()(const f32x4 (&acc)[2][2][4][2], const Unit& u, int wr, int wc, int fr, int fq, const Pre&) const {
        const int row0 = u.pm * BM + wr * 64 + fr, col0 = u.pn * BM + wc * 32 + 8 * fq;
        f32x4 bs[2][2];
#pragma unroll
        for (int bj = 0; bj < 2; ++bj) { bs[bj][0] = *(const f32x4*)(bias + col0 + bj * HALF); bs[bj][1] = *(const f32x4*)(bias + col0 + bj * HALF + 4); }
#pragma unroll
        for (int bj = 0; bj < 2; ++bj) { const int c = col0 + bj * HALF;
#pragma unroll
            for (int ai = 0; ai < 2; ++ai) { u32x4 zv[4], gv[4];
#pragma unroll
                for (int m = 0; m < 4; ++m) { const int r = row0 + ai * HALF + m * 16; zv[m] = __builtin_nontemporal_load((const u32x4*)(Z + (size_t)r * DE2 + c)); gv[m] = __builtin_nontemporal_load((const u32x4*)(Gm + (size_t)(c >> 4) * GSTR + r * 16 + (c & 15))); }
#pragma unroll
                for (int m = 0; m < 4; ++m) { const int r = row0 + ai * HALF + m * 16;
                    const u32x4 zw = zv[m], gw = gv[m];
                    const f32x4 a0 = acc[ai][bj][m][0] + bs[bj][0], a1 = acc[ai][bj][m][1] + bs[bj][1];
                    u32x4 w;
                    w.x = cvt_pk_bf16(glu_gate_f(bf_lo(gw.x), a0[0], bf_lo(zw.x)), glu_gate_f(bf_hi(gw.x), a0[1], bf_hi(zw.x)));
                    w.y = cvt_pk_bf16(glu_gate_f(bf_lo(gw.y), a0[2], bf_lo(zw.y)), glu_gate_f(bf_hi(gw.y), a0[3], bf_hi(zw.y)));
                    w.z = cvt_pk_bf16(glu_gate_f(bf_lo(gw.z), a1[0], bf_lo(zw.z)), glu_gate_f(bf_hi(gw.z), a1[1], bf_hi(zw.z)));
                    w.w = cvt_pk_bf16(glu_gate_f(bf_lo(gw.w), a1[2], bf_lo(zw.w)), glu_gate_f(bf_hi(gw.w), a1[3], bf_hi(zw.w)));
                    *(u32x4*)(O + (size_t)r * DE + c) = w; } } }
    }
};
struct EpiOut {
    static constexpr bool AFTER_DRAIN = false;
    static constexpr bool PERM = false;
    const float* Xin; float* X; bf16_t* H; const float* gnext; float* rowss_next;
    struct Pre {};
    __device__ __forceinline__ Pre pre(const Unit&, int, int) const { return Pre{}; }
    __device__ __forceinline__ void operator()(const f32x4 (&acc)[2][2][4][2], const Unit& u, int wr, int wc, int fr, int fq, const Pre&) const {
        const int row0 = u.pm * BM + wr * 64 + fr, col0 = u.pn * BM + wc * 32 + 4 * fq;
        f32x4 gv[2][2];
#pragma unroll
        for (int bj = 0; bj < 2; ++bj)
#pragma unroll
            for (int n = 0; n < 2; ++n) gv[bj][n] = *(const f32x4*)(gnext + col0 + bj * HALF + n * 16);
        f32x4 xb[2][2][2];
#pragma unroll
        for (int bj = 0; bj < 2; ++bj)
#pragma unroll
            for (int n = 0; n < 2; ++n) xb[0][bj][n] = *(const f32x4*)(Xin + (size_t)row0 * DM + col0 + bj * HALF + n * 16);
#pragma unroll
        for (int grp = 0; grp < 8; ++grp) { const int ai = grp >> 2, m = grp & 3, cur = grp & 1; const int r = row0 + ai * HALF + m * 16; float ss = 0.f;
            if (grp < 7) { const int rn = row0 + ((grp + 1) >> 2) * HALF + ((grp + 1) & 3) * 16;
#pragma unroll
                for (int bj = 0; bj < 2; ++bj)
#pragma unroll
                    for (int n = 0; n < 2; ++n) xb[cur ^ 1][bj][n] = *(const f32x4*)(Xin + (size_t)rn * DM + col0 + bj * HALF + n * 16); }
#pragma unroll
            for (int bj = 0; bj < 2; ++bj)
#pragma unroll
                for (int n = 0; n < 2; ++n) { const int c = col0 + bj * HALF + n * 16;
                    const f32x4 xv = xb[cur][bj][n] + acc[ai][bj][m][n]; *(f32x4*)(X + (size_t)r * DM + c) = xv;
                    ss += (xv[0] * xv[0] + xv[1] * xv[1]) + (xv[2] * xv[2] + xv[3] * xv[3]);
                    if (H) { const f32x4 hv = xv * gv[bj][n]; u32x2 w; w.x = cvt_pk_bf16(hv[0], hv[1]); w.y = cvt_pk_bf16(hv[2], hv[3]);
                        *(u32x2*)(H + (size_t)r * DM + c) = w; } }
            ss += __shfl_xor(ss, 16); ss += __shfl_xor(ss, 32);
            if (fq == 0) atomicAdd(rowss_next + r, ss); }
    }
};
struct EpiOutFinal {
    static constexpr bool AFTER_DRAIN = true;
    static constexpr bool PERM = false;
    const float* Xin; float* Out; const float* gfin; float* rowss; unsigned* cnt;
    struct Pre {};
    __device__ __forceinline__ Pre pre(const Unit&, int, int) const { return Pre{}; }
    __device__ __forceinline__ void fused(f32x4 (&acc)[2][2][4][2], const Unit& u, int wr, int wc, int fr, int fq) const {
        const int row0 = u.pm * BM + wr * 64 + fr, col0 = u.pn * BM + wc * 32 + 4 * fq;
        f32x4 xb[2][2][2];
#pragma unroll
        for (int bj = 0; bj < 2; ++bj)
#pragma unroll
            for (int n = 0; n < 2; ++n) xb[0][bj][n] = *(const f32x4*)(Xin + (size_t)row0 * DM + col0 + bj * HALF + n * 16);
#pragma unroll
        for (int grp = 0; grp < 8; ++grp) { const int ai = grp >> 2, m = grp & 3, cur = grp & 1; const int r = row0 + ai * HALF + m * 16; float ss = 0.f;
            if (grp < 7) { const int rn = row0 + ((grp + 1) >> 2) * HALF + ((grp + 1) & 3) * 16;
#pragma unroll
                for (int bj = 0; bj < 2; ++bj)
#pragma unroll
                    for (int n = 0; n < 2; ++n) xb[cur ^ 1][bj][n] = *(const f32x4*)(Xin + (size_t)rn * DM + col0 + bj * HALF + n * 16); }
#pragma unroll
            for (int bj = 0; bj < 2; ++bj)
#pragma unroll
                for (int n = 0; n < 2; ++n) { const f32x4 xv = xb[cur][bj][n] + acc[ai][bj][m][n]; acc[ai][bj][m][n] = xv;
                    ss += (xv[0] * xv[0] + xv[1] * xv[1]) + (xv[2] * xv[2] + xv[3] * xv[3]); }
            ss += __shfl_xor(ss, 16); ss += __shfl_xor(ss, 32);
            if (fq == 0) atomicAdd(rowss + r, ss); }
        asm volatile("s_waitcnt vmcnt(0)" ::: "memory");
        __syncthreads();
        if (threadIdx.x == 0) { unsigned* c = cnt + 64 * u.pm;
            __hip_atomic_fetch_add(c, 1u, __ATOMIC_RELAXED, __HIP_MEMORY_SCOPE_AGENT);
            unsigned sp = 0;
            while (__hip_atomic_load(c, __ATOMIC_RELAXED, __HIP_MEMORY_SCOPE_AGENT) < 8u) { __builtin_amdgcn_s_sleep(2); if (++sp > (1u << 22)) break; } }
        __syncthreads();
        f32x4 gv[2][2]; float rs[8];
#pragma unroll
        for (int bj = 0; bj < 2; ++bj)
#pragma unroll
            for (int n = 0; n < 2; ++n) gv[bj][n] = *(const f32x4*)(gfin + col0 + bj * HALF + n * 16);
#pragma unroll
        for (int g8 = 0; g8 < 8; ++g8) rs[g8] = __hip_atomic_load(rowss + row0 + (g8 >> 2) * HALF + (g8 & 3) * 16, __ATOMIC_RELAXED, __HIP_MEMORY_SCOPE_AGENT);
#pragma unroll
        for (int ai = 0; ai < 2; ++ai)
#pragma unroll
            for (int m = 0; m < 4; ++m) { const int r = row0 + ai * HALF + m * 16; const float inv = rsqrtf(rs[ai * 4 + m] * (1.0f / DM) + EPS);
#pragma unroll
                for (int bj = 0; bj < 2; ++bj)
#pragma unroll
                    for (int n = 0; n < 2; ++n) *(f32x4*)(Out + (size_t)r * DM + col0 + bj * HALF + n * 16) = acc[ai][bj][m][n] * inv * gv[bj][n]; }
    }
};
}

#define LDS_BARRIER() asm volatile("s_waitcnt lgkmcnt(0)\n\ts_barrier" ::: "memory")
struct CvtJob { const float* src; bf16_t* dst; int K, N, k0, n0; };
constexpr int N_CVT_TILES_K = 2 * 4352;
__device__ __forceinline__ CvtJob cvt_decode(int t, const ParamsPtr pq) {
    t = N_CVT_TILES_K - 1 - t;
    CvtJob J; const int jj = t / 4352; int r = t % 4352; unsigned char* ws = pq->ws;
    if (r < 1792) { bf16_t* wp = (bf16_t*)(ws + WS_W + jj * W_POOL_SZ);
        if (r < 1024) { J.src = pq->in[3] + (size_t)jj * DM * DE2; J.dst = wp + W_POOL_IN / 2; J.K = DM; J.N = DE2; }
        else if (r < 1280) { r -= 1024; const int g = r >> 6; r &= 63; J.src = pq->in[4] + ((size_t)jj * 4 + g) * 1024 * 1024; J.dst = wp + W_POOL_GRP / 2 + (size_t)g * 1024 * 1024; J.K = 1024; J.N = 1024; }
        else { r -= 1280; J.src = pq->in[6] + (size_t)jj * DE * DM; J.dst = wp + W_POOL_OUT / 2; J.K = DE; J.N = DM; }
    } else { r -= 1792; bf16_t* wp = (bf16_t*)(ws + WS_WSSM + jj * W_SSM_SZ);
        if (r < 1024) { J.src = pq->in[7] + (size_t)jj * DM * DE2; J.dst = wp + W_SSM_IN / 2; J.K = DM; J.N = DE2; }
        else if (r < 2048) { r -= 1024; J.src = pq->in[16] + (size_t)jj * DE * DE; J.dst = wp + W_SSM_GLU / 2; J.K = DE; J.N = DE; }
        else { r -= 2048; J.src = pq->in[18] + (size_t)jj * DE * DM; J.dst = wp + W_SSM_OUT / 2; J.K = DE; J.N = DM; }
    }
    const int tn = J.N / 256; J.k0 = (r / tn) * 64; J.n0 = (r % tn) * 256; return J;
}
constexpr int N_CVT_TILES = 2 * 4352;
__device__ void convert_weights(float* tile) {
    const ParamsPtr pq = params_ptr();
    const int tid = fresh_tid(), rl = tid >> 6, c4 = (tid & 63) * 4;
    float4 cur[8];
    int t = blockIdx.x;
    if (t < N_CVT_TILES) { const CvtJob J = cvt_decode(t, pq);
#pragma unroll
        for (int ii = 0; ii < 8; ++ii) { const f32x4 t_ = __builtin_nontemporal_load((const f32x4*)(J.src + (size_t)(J.k0 + ii * 8 + rl) * J.N + J.n0 + c4)); cur[ii] = make_float4(t_[0], t_[1], t_[2], t_[3]); } }
    for (; t < N_CVT_TILES; t += gridDim.x) {
        const CvtJob J = cvt_decode(t, pq);
#pragma unroll
        for (int ii = 0; ii < 8; ++ii) { float* tp = tile + (ii * 8 + rl) * 257 + c4; tp[0] = cur[ii].x; tp[1] = cur[ii].y; tp[2] = cur[ii].z; tp[3] = cur[ii].w; }
        const int tn = t + gridDim.x;
        if (tn < N_CVT_TILES) { const CvtJob Jn = cvt_decode(tn, pq);
#pragma unroll
            for (int ii = 0; ii < 8; ++ii) { const f32x4 t_ = __builtin_nontemporal_load((const f32x4*)(Jn.src + (size_t)(Jn.k0 + ii * 8 + rl) * Jn.N + Jn.n0 + c4)); cur[ii] = make_float4(t_[0], t_[1], t_[2], t_[3]); } }
        LDS_BARRIER();
#pragma unroll
        for (int ii = 0; ii < 4; ++ii) { const int f = tid + 512 * ii, n = f >> 3, k8 = (f & 7) * 8; const float* tp = tile + k8 * 257 + n;
            u32x4 w; w.x = cvt_pk_bf16(tp[0], tp[257]); w.y = cvt_pk_bf16(tp[2 * 257], tp[3 * 257]); w.z = cvt_pk_bf16(tp[4 * 257], tp[5 * 257]); w.w = cvt_pk_bf16(tp[6 * 257], tp[7 * 257]);
            *(u32x4*)(J.dst + (size_t)(J.n0 + n) * J.K + J.k0 + k8) = w; }
        LDS_BARRIER();
    }
}

__device__ void phase_prep(float* ldsf) {
    const ParamsPtr pq = params_ptr(); Params p;
#pragma unroll
    for (int i = 0; i < 19; ++i) p.in[i] = pq->in[i];
    p.out = pq->out; p.ws = pq->ws; p.ph_lo = 0; p.ph_hi = 0;
    const int tid = fresh_tid(), lane = tid & 63, wave = tid >> 6;
    const float* x = p.in[0]; const float* g0 = p.in[1];
    bf16_t* hbf = (bf16_t*)(p.ws + WS_HBF); float* rowss = (float*)(p.ws + WS_ROWSS);
    for (int i = blockIdx.x * NTHREADS + tid; i < 4 * M_TOK; i += gridDim.x * NTHREADS) rowss[M_TOK + i] = 0.f;
    convert_weights(ldsf);
    float4 gq[8];
#pragma unroll
    for (int i = 0; i < 8; ++i) gq[i] = ((const float4*)g0)[i * 64 + lane];
    for (int row = blockIdx.x * 8 + wave; row < M_TOK; row += gridDim.x * 8) {
        const float4* xr = (const float4*)(x + (size_t)row * DM);
        float4 xv[8];
#pragma unroll
        for (int i = 0; i < 8; ++i) xv[i] = xr[i * 64 + lane];
        float ss = 0.f;
#pragma unroll
        for (int i = 0; i < 8; ++i) { const int idx = i * 64 + lane; const float4 v = xv[i];
            ss += (v.x * v.x + v.y * v.y) + (v.z * v.z + v.w * v.w);
            u32x2 w; w.x = cvt_pk_bf16(v.x * gq[i].x, v.y * gq[i].y); w.y = cvt_pk_bf16(v.z * gq[i].z, v.w * gq[i].w);
            *(u32x2*)(hbf + (size_t)row * DM + idx * 4) = w; }
#pragma unroll
        for (int o = 32; o >= 1; o >>= 1) ss += __shfl_xor(ss, o);
        if (lane == 0) rowss[row] = ss;
    }
}

__device__ void phase_pool() {
    const ParamsPtr p_ = params_ptr(); unsigned char* ws = p_->ws;
    const bf16_t* uz = (const bf16_t*)(ws + WS_UZ); bf16_t* pg = (bf16_t*)(ws + WS_PG);
    constexpr int RB = 32;
    for (int idx = blockIdx.x * NTHREADS + fresh_tid(); idx < (M_TOK / RB) * (DE / 8); idx += gridDim.x * NTHREADS) {
        const int c8 = idx % (DE / 8), rb = idx / (DE / 8), col = c8 * 8, g = col >> 10, w = 2 << g, row0 = rb * RB, tl0 = row0 & (SEQ - 1);
        float s[8];
#pragma unroll
        for (int i = 0; i < 8; ++i) s[i] = 0.f;
        const int nh = (tl0 < w) ? tl0 : w;
        { u32x4 hv[16];
#pragma unroll
          for (int k = 1; k <= 16; ++k) hv[k - 1] = (k <= nh) ? *(const u32x4*)(uz + (size_t)(row0 - k) * DE2 + col) : (u32x4){0u, 0u, 0u, 0u};
#pragma unroll
          for (int k = 0; k < 16; ++k) { const u32x4 v = hv[k];
            s[0] += bf_lo(v.x); s[1] += bf_hi(v.x); s[2] += bf_lo(v.y); s[3] += bf_hi(v.y); s[4] += bf_lo(v.z); s[5] += bf_hi(v.z); s[6] += bf_lo(v.w); s[7] += bf_hi(v.w); } }
#pragma unroll 1
        for (int r0 = 0; r0 < RB; r0 += 8) {
            u32x4 vv[8], ov[8];
#pragma unroll
            for (int k = 0; k < 8; ++k) { const int row = row0 + r0 + k, tl = tl0 + r0 + k;
                vv[k] = *(const u32x4*)(uz + (size_t)row * DE2 + col);
                ov[k] = (tl >= w) ? __builtin_nontemporal_load((const u32x4*)(uz + (size_t)(row - w) * DE2 + col)) : (u32x4){0u, 0u, 0u, 0u}; }
#pragma unroll
            for (int k = 0; k < 8; ++k) { const int row = row0 + r0 + k, tl = tl0 + r0 + k; const u32x4 v = vv[k], o2 = ov[k];
                s[0] += bf_lo(v.x) - bf_lo(o2.x); s[1] += bf_hi(v.x) - bf_hi(o2.x); s[2] += bf_lo(v.y) - bf_lo(o2.y); s[3] += bf_hi(v.y) - bf_hi(o2.y);
                s[4] += bf_lo(v.z) - bf_lo(o2.z); s[5] += bf_hi(v.z) - bf_hi(o2.z); s[6] += bf_lo(v.w) - bf_lo(o2.w); s[7] += bf_hi(v.w) - bf_hi(o2.w);
                const float ic = 1.0f / (float)((tl + 1 < w) ? tl + 1 : w);
                u32x4 o;
                o.x = cvt_pk_bf16(s[0] * ic - bf_lo(v.x), s[1] * ic - bf_hi(v.x)); o.y = cvt_pk_bf16(s[2] * ic - bf_lo(v.y), s[3] * ic - bf_hi(v.y));
                o.z = cvt_pk_bf16(s[4] * ic - bf_lo(v.z), s[5] * ic - bf_hi(v.z)); o.w = cvt_pk_bf16(s[6] * ic - bf_lo(v.w), s[7] * ic - bf_hi(v.w));
                *(u32x4*)(pg + (size_t)row * DE + col) = o; }
        }
    }
}

typedef float f32x16 __attribute__((ext_vector_type(16)));
constexpr int SEGC = 64, U_PITCH = 528, S_PITCH = 132, H_PITCH = 272;
constexpr int L_APOW = 0, L_BBAR = L_APOW + 64 * 17 * 8, L_CC = L_BBAR + 64 * 17 * 8, L_KT = L_CC + 16 * 65 * 8, L_UBUF = L_KT + 16 * 16 * 20 * 4,
              L_SBUF = L_UBUF + SEGC * U_PITCH, L_HBUF = L_SBUF + SEGC * S_PITCH * 4, L_SSM_END = L_HBUF + SEGC * H_PITCH;
constexpr int L_FS = L_CC, L_UB = L_FS + 4 * 16 * 64 * 16, L_SB = L_UB + SEGC * U_PITCH;
constexpr int L_EX = L_SB + SEGC * S_PITCH * 4;
constexpr int L_D = L_EX + 8 * 64 * 8;
static_assert(L_D + 64 <= XB_LDS_OFF && S_PITCH * 4 == U_PITCH, "SSM LDS budget");
typedef float __attribute__((may_alias)) f32a; typedef unsigned short __attribute__((may_alias)) u16a;
__device__ __forceinline__ bf16x8 pack8(const float (&v)[8]) {
    u32x4 w; w.x = cvt_pk_bf16(v[0], v[1]); w.y = cvt_pk_bf16(v[2], v[3]); w.z = cvt_pk_bf16(v[4], v[5]); w.w = cvt_pk_bf16(v[6], v[7]);
    return __builtin_bit_cast(bf16x8, w);
}
__device__ void phase_ssm(int j, unsigned char* lds) {
    const ParamsPtr pq = params_ptr();
    unsigned char* ws = pq->ws;
    const int tid = fresh_tid(), lane = tid & 63, wave = __builtin_amdgcn_readfirstlane(tid >> 6), l31 = lane & 31, h = lane >> 5;
    const bf16_t* UG = (const bf16_t*)(ws + WS_GATED); bf16_t* GO = (bf16_t*)(ws + WS_PG);
    f32x2* APOW = (f32x2*)(lds + L_APOW); f32x2* BBAR = (f32x2*)(lds + L_BBAR); f32x2* CC = (f32x2*)(lds + L_CC); float* KT = (float*)(lds + L_KT);
    for (int g = blockIdx.x; g < NG; g += gridDim.x) {
        __syncthreads();
        u32x4 pf[4];
        { const bf16_t* usrc = UG + (size_t)g * GSTR;
#pragma unroll
          for (int it = 0; it < 4; ++it) pf[it] = __builtin_nontemporal_load((const u32x4*)(usrc + (size_t)(tid + NTHREADS * it) * 8)); }
        { f32x4* TMP = (f32x4*)(lds + L_UBUF);
          if (tid < 64) { const int n = tid;
            const float are = pq->in[8][((size_t)j * NG + g) * NS + n], aim = pq->in[9][((size_t)j * NG + g) * NS + n];
            const float dt = expf(pq->in[10][(size_t)j * NG + g]);
            const float mag = expf(are * dt); float sn, cs; sincosf(aim * dt, &sn, &cs);
            const float abr = mag * cs, abi = mag * sn, den = are * are + aim * aim, nr = abr - 1.0f;
            TMP[n] = (f32x4){are * dt, aim * dt, (nr * are + abi * aim) / den, (abi * are - nr * aim) / den}; }
          __syncthreads();
          for (int i = tid; i < 64 * 17; i += NTHREADS) { const int n = i / 17, k = i - n * 17; const f32x4 t4 = TMP[n];
              const float mg = expf(t4[0] * (float)k); float sn, cs; sincosf(t4[1] * (float)k, &sn, &cs); APOW[i] = (f32x2){mg * cs, mg * sn}; }
          for (int i = tid; i < NS * NP; i += NTHREADS) { const int n = i >> 4; const f32x4 t4 = TMP[n]; const size_t o = ((size_t)j * NG + g) * NS * NP + i;
              const float bre = pq->in[11][o], bim = pq->in[12][o]; BBAR[n * 17 + (i & 15)] = (f32x2){t4[2] * bre - t4[3] * bim, t4[2] * bim + t4[3] * bre}; }
          for (int i = tid; i < NP * NS; i += NTHREADS) { const size_t o = ((size_t)j * NG + g) * NP * NS + i; CC[(i >> 6) * 65 + (i & 63)] = (f32x2){pq->in[13][o], pq->in[14][o]}; }
          __syncthreads();
          { const int tau = tid >> 5, q = (tid >> 1) & 15, ph = tid & 1; float ka[8];
#pragma unroll
            for (int i = 0; i < 8; ++i) ka[i] = 0.f;
#pragma unroll 1
            for (int n0 = 0; n0 < NS; n0 += 4) { f32x2 a[4], b[4], c[4][8];
#pragma unroll
                for (int u = 0; u < 4; ++u) { a[u] = APOW[(n0 + u) * 17 + tau]; b[u] = BBAR[(n0 + u) * 17 + q];
#pragma unroll
                    for (int i = 0; i < 8; ++i) c[u][i] = CC[(ph * 8 + i) * 65 + n0 + u]; }
                __builtin_amdgcn_sched_barrier(0);
#pragma unroll
                for (int u = 0; u < 4; ++u) { const float xr = a[u].x * b[u].x - a[u].y * b[u].y, xi = a[u].x * b[u].y + a[u].y * b[u].x;
#pragma unroll
                    for (int i = 0; i < 8; ++i) ka[i] += c[u][i].x * xr - c[u][i].y * xi; } }
#pragma unroll
            for (int i = 0; i < 8; ++i) KT[(tau * 16 + ph * 8 + i) * 20 + q] = ka[i]; }
          __syncthreads(); }
        const int mb1 = wave & 3, cb1 = wave >> 2, mb3 = (wave < 4) ? wave : 11 - wave;
        bf16x8 FT[16], FH[8];
        const int jrow = 2 * mb3 + (l31 >> 4), prow = l31 & 15;
#pragma unroll
        for (int j4 = 0; j4 < 4; ++j4) { f32x4 k0[4], k1[4];
#pragma unroll
            for (int u = 0; u < 4; ++u) { const int jp = 4 * j4 + u; const float* kt = KT + (((jrow - jp) & 15) * 16 + prow) * 20 + 8 * h; k0[u] = *(const f32x4*)kt; k1[u] = *(const f32x4*)(kt + 4); }
            __builtin_amdgcn_sched_barrier(0);
#pragma unroll
            for (int u = 0; u < 4; ++u) { const int jp = 4 * j4 + u; float v[8];
#pragma unroll
                for (int i = 0; i < 4; ++i) { v[i] = (jp <= jrow) ? k0[u][i] : 0.f; v[4 + i] = (jp <= jrow) ? k1[u][i] : 0.f; }
                FT[jp] = pack8(v); } }
#pragma unroll
        for (int ks = 0; ks < 8; ++ks) { f32x2 c[8], a[8];
#pragma unroll
            for (int i = 0; i < 8; ++i) { const int n = (ks * 16 + 8 * h + i) & 63; c[i] = CC[prow * 65 + n]; a[i] = APOW[n * 17 + jrow + 1]; }
            __builtin_amdgcn_sched_barrier(0);
            float v[8];
#pragma unroll
            for (int i = 0; i < 8; ++i) v[i] = (ks >= 4) ? -(c[i].x * a[i].y + c[i].y * a[i].x) : (c[i].x * a[i].x - c[i].y * a[i].y);
            FH[ks] = pack8(v); }
        const f32x2 A16 = APOW[lane * 17 + 16];
        f32x2 A128 = A16;
#pragma unroll
        for (int i = 0; i < 3; ++i) A128 = (f32x2){A128.x * A128.x - A128.y * A128.y, 2.0f * A128.x * A128.y};
        __syncthreads();
#pragma unroll 1
        for (int k = 0; k < 8; ++k) { const int e = tid + NTHREADS * k, el = e & 63, jp = (e >> 6) & 15, mb = e >> 10, m = 32 * mb + (el & 31), n = m & 63, eh = el >> 5; const bool im = m >= 64;
            const f32x2 a = APOW[n * 17 + 15 - jp]; f32x2 b[8]; float v[8];
#pragma unroll
            for (int i = 0; i < 8; ++i) b[i] = BBAR[n * 17 + 8 * eh + i];
            __builtin_amdgcn_sched_barrier(0);
#pragma unroll
            for (int i = 0; i < 8; ++i) v[i] = im ? (a.x * b[i].y + a.y * b[i].x) : (a.x * b[i].x - a.y * b[i].y);
            *(bf16x8*)(lds + L_FS + e * 16) = pack8(v); }
        const float* dsk = pq->in[15] + (size_t)j * DE + g * NP;
        if (tid < 16) ((float*)(lds + L_D))[tid] = dsk[tid];
        const bf16_t* ug = UG + (size_t)g * GSTR; bf16_t* gbase = GO + (size_t)g * GSTR;
        float hr = 0.f, hi = 0.f;
        for (int seg = 0; seg < 8; ++seg) {
            LDS_BARRIER();
#pragma unroll
            for (int it = 0; it < 4; ++it) { const int pid = tid + NTHREADS * it, tt = pid >> 1, half = pid & 1;
                *(u32x4*)(lds + L_UB + (tt >> 4) * U_PITCH + (tt & 15) * 32 + half * 16) = pf[it]; }
            if (seg < 7) {
#pragma unroll
                for (int it = 0; it < 4; ++it) pf[it] = __builtin_nontemporal_load((const u32x4*)(ug + (size_t)(seg + 1) * (SEGC * TCH * 16) + (size_t)(tid + NTHREADS * it) * 8)); }
            LDS_BARRIER();
            { f32x16 acc;
#pragma unroll
              for (int i = 0; i < 16; ++i) acc[i] = 0.f;
              const unsigned char* ub = lds + L_UB + (cb1 * 32 + l31) * U_PITCH + h * 16; const unsigned char* fs = lds + L_FS + (mb1 * 16 * 64 + lane) * 16;
#pragma unroll
              for (int g4 = 0; g4 < 2; ++g4) { bf16x8 A[8], B[8];
#pragma unroll
                  for (int i = 0; i < 8; ++i) { A[i] = *(const bf16x8*)(fs + (g4 * 8 + i) * 1024); B[i] = *(const bf16x8*)(ub + (g4 * 8 + i) * 32); }
#pragma unroll
                  for (int i = 0; i < 8; ++i) acc = __builtin_amdgcn_mfma_f32_32x32x16_bf16(A[i], B[i], acc, 0, 0, 0);
                  }
              float* sp = (float*)(lds + L_SB) + (cb1 * 32 + l31) * S_PITCH + 32 * mb1 + 4 * h;
#pragma unroll
              for (int rr = 0; rr < 4; ++rr) *(f32x4*)(sp + 8 * rr) = (f32x4){acc[4 * rr], acc[4 * rr + 1], acc[4 * rr + 2], acc[4 * rr + 3]}; }
            LDS_BARRIER();
            { const f32a* sb = (const f32a*)(lds + L_SB) + (8 * wave) * S_PITCH + lane; float sr[8], si[8];
#pragma unroll
              for (int k = 0; k < 8; ++k) { sr[k] = sb[k * S_PITCH]; si[k] = sb[k * S_PITCH + 64]; }
              float lr = 0.f, li = 0.f;
#pragma unroll
              for (int k = 0; k < 8; ++k) { const float nr = A16.x * lr - A16.y * li + sr[k], ni = A16.x * li + A16.y * lr + si[k]; lr = nr; li = ni; }
              *(f32x2*)(lds + L_EX + (wave * 64 + lane) * 8) = (f32x2){lr, li}; }
            LDS_BARRIER();
            { if ((seg & 3) == 0) { hr = 0.f; hi = 0.f; }
              float xr = hr, xi = hi, mr = hr, mi = hi;
              f32x2 ev[8];
#pragma unroll
              for (int v = 0; v < 8; ++v) ev[v] = *(const f32x2*)(lds + L_EX + (v * 64 + lane) * 8);
#pragma unroll
              for (int v = 0; v < 8; ++v) { mr = (v == wave) ? xr : mr; mi = (v == wave) ? xi : mi;
                  const float nr = A128.x * xr - A128.y * xi + ev[v].x, ni = A128.x * xi + A128.y * xr + ev[v].y; xr = nr; xi = ni; }
              hr = xr; hi = xi;
              const f32a* sb = (const f32a*)(lds + L_SB) + (8 * wave) * S_PITCH + lane; float sr[8], si[8];
#pragma unroll
              for (int k = 0; k < 8; ++k) { sr[k] = sb[k * S_PITCH]; si[k] = sb[k * S_PITCH + 64]; }
              u16a* hb = (u16a*)(lds + L_SB) + (8 * wave) * (2 * S_PITCH) + lane; float yr = mr, yi = mi;
#pragma unroll
              for (int k = 0; k < 8; ++k) { const unsigned pk = cvt_pk_bf16(yr, yi); hb[k * (2 * S_PITCH)] = (unsigned short)(pk & 0xffffu); hb[k * (2 * S_PITCH) + 64] = (unsigned short)(pk >> 16);
                  const float nr = A16.x * yr - A16.y * yi + sr[k], ni = A16.x * yi + A16.y * yr + si[k]; yr = nr; yi = ni; } }
            LDS_BARRIER();
#pragma unroll 1
            for (int cb = 0; cb < 2; ++cb) {
                f32x16 acc;
#pragma unroll
                for (int i = 0; i < 16; ++i) acc[i] = 0.f;
                const int ch = cb * 32 + l31;
                const unsigned char* ub0 = lds + L_UB + ch * U_PITCH + h * 16; const unsigned char* hb0 = lds + L_SB + ch * (S_PITCH * 4) + h * 16;
#pragma unroll
                for (int g8 = 0; g8 < 2; ++g8) if (8 * g8 <= 2 * mb3 + 1) { bf16x8 B[8];
#pragma unroll
                    for (int i = 0; i < 8; ++i) B[i] = *(const bf16x8*)(ub0 + (g8 * 8 + i) * 32);
#pragma unroll
                    for (int i = 0; i < 8; ++i) acc = __builtin_amdgcn_mfma_f32_32x32x16_bf16(FT[g8 * 8 + i], B[i], acc, 0, 0, 0); }
                { bf16x8 B[8];
#pragma unroll
                    for (int i = 0; i < 8; ++i) B[i] = *(const bf16x8*)(hb0 + i * 32);
#pragma unroll
                    for (int i = 0; i < 8; ++i) acc = __builtin_amdgcn_mfma_f32_32x32x16_bf16(FH[i], B[i], acc, 0, 0, 0); }
                u32x2 uwv[4]; const f32x4 dA = *(const f32x4*)(lds + L_D + 16 * h), dB = *(const f32x4*)(lds + L_D + 32 + 16 * h);
#pragma unroll
                for (int rr = 0; rr < 4; ++rr) uwv[rr] = *(const u32x2*)(lds + L_UB + ch * U_PITCH + (2 * mb3 + (rr >> 1)) * 32 + (8 * (rr & 1) + 4 * h) * 2);
#pragma unroll
                for (int rr = 0; rr < 4; ++rr) { const int jj = 2 * mb3 + (rr >> 1), p0 = 8 * (rr & 1) + 4 * h;
                    const u32x2 uw = uwv[rr]; const f32x4 d4 = (rr & 1) ? dB : dA;
                    const float y0 = acc[4 * rr] + d4[0] * bf_lo(uw.x), y1 = acc[4 * rr + 1] + d4[1] * bf_hi(uw.x);
                    const float y2 = acc[4 * rr + 2] + d4[2] * bf_lo(uw.y), y3 = acc[4 * rr + 3] + d4[3] * bf_hi(uw.y);
                    u32x2 o; o.x = cvt_pk_bf16(gelu_tanh_f(y0), gelu_tanh_f(y1)); o.y = cvt_pk_bf16(gelu_tanh_f(y2), gelu_tanh_f(y3));
                    *(u32x2*)(gbase + ((size_t)seg * (SEGC * TCH) + ch * TCH + jj) * 16 + p0) = o; }
            }
        }
        __syncthreads();
    }
}

__device__ void phase_final() {
    const ParamsPtr pq = params_ptr(); struct { const float* in[3]; float* out; unsigned char* ws; } p{{pq->in[0], pq->in[1], pq->in[2]}, pq->out, pq->ws};
    const float* rowss = (const float*)(p.ws + WS_ROWSS) + 4 * M_TOK; const float* gf = p.in[2];
    const int tid = fresh_tid(), lane = tid & 63, wave = tid >> 6;
    for (int row = blockIdx.x * 8 + wave; row < M_TOK; row += gridDim.x * 8) {
        const float inv = rsqrtf(rowss[row] * (1.0f / DM) + EPS); float4* xr = (float4*)(p.out + (size_t)row * DM);
        float4 xv[8], gv[8];
#pragma unroll
        for (int i = 0; i < 8; ++i) { xv[i] = xr[i * 64 + lane]; gv[i] = ((const float4*)gf)[i * 64 + lane]; }
#pragma unroll
        for (int i = 0; i < 8; ++i) { float4 v = xv[i]; const float4 g = gv[i];
            v.x *= inv * g.x; v.y *= inv * g.y; v.z *= inv * g.z; v.w *= inv * g.w; xr[i * 64 + lane] = v; }
    }
}

#define XB_TMO      128
#define XB_XCNT(j)  (256  + 64 * (j))
#define XB_XSUB(j)  (1280 + 64 * (j))
#define XB_XGEN(j)  (2304 + 64 * (j))
#define XB_TOP      3328
#define XB_TOPGEN   3392
#define XCD_BAR_WORDS 3456
#define XB_SPIN_CAP (1u << 18)
__device__ __forceinline__ unsigned xb_ld(unsigned* p)              { return __hip_atomic_load(p, __ATOMIC_RELAXED, __HIP_MEMORY_SCOPE_AGENT); }
__device__ __forceinline__ unsigned xb_add(unsigned* p, unsigned v) { return __hip_atomic_fetch_add(p, v, __ATOMIC_RELAXED, __HIP_MEMORY_SCOPE_AGENT); }
__device__ __forceinline__ unsigned xb_xcc_id() { return (unsigned)__builtin_amdgcn_s_getreg((3 << 11) | 20) & 0xFu; }
#define XB_SPIN(cond, bar) do { unsigned _sp = 0; while (cond) { __builtin_amdgcn_s_sleep(1); \
    if ((++_sp & 255u) == 0u) { if (xb_ld(&(bar)[XB_TMO])) break; if (_sp > XB_SPIN_CAP) { atomicAdd(&(bar)[XB_TMO], 1u); break; } } } } while (0)
struct XcdBarrier { unsigned* bar; unsigned x; volatile LAS unsigned* st; };
__device__ __forceinline__ XcdBarrier xcd_barrier_post(unsigned* bar, volatile LAS unsigned* st) {
    XcdBarrier b; b.bar = bar; b.x = xb_xcc_id(); b.st = st;
    if (threadIdx.x == 0) (void)xb_add(&bar[XB_XCNT(b.x)], 1u);
    return b;
}
__device__ __forceinline__ void xcd_barrier_complete(unsigned* bar, unsigned x, unsigned& nloc, unsigned& nx) {
    const unsigned G = gridDim.x * gridDim.y * gridDim.z;
    unsigned sum, cnt, mine, sp = 0u;
    for (;;) {
        sum = 0u; cnt = 0u; mine = 0u;
#pragma unroll
        for (unsigned j = 0; j < 16; ++j) { const unsigned c = xb_ld(&bar[XB_XCNT(j)]); sum += c; cnt += (c > 0u) ? 1u : 0u; mine = (j == x) ? c : mine; }
        if (sum == G) break;
        __builtin_amdgcn_s_sleep(1);
        if ((++sp & 255u) == 0u) { if (xb_ld(&bar[XB_TMO])) break; if (sp > XB_SPIN_CAP) { atomicAdd(&bar[XB_TMO], 1u); break; } }
    }
    nloc = mine > 0u ? mine : 1u; nx = cnt > 0u ? cnt : 1u;
}
__device__ __forceinline__ void xcd_barrier(const XcdBarrier& b) {
    asm volatile("s_waitcnt vmcnt(0)" ::: "memory");
    __syncthreads();
    if (threadIdx.x == 0) {
        unsigned* bar = b.bar;
        __builtin_amdgcn_s_waitcnt(0);
        unsigned nloc = b.st[0], nx = b.st[1];
        if (nloc == 0u) { xcd_barrier_complete(bar, b.x, nloc, nx); b.st[0] = nloc; b.st[1] = nx; }
        const unsigned old = xb_add(&bar[XB_XSUB(b.x)], 1u);
        const unsigned gen = old / nloc;
        if (old + 1u == (gen + 1u) * nloc) {
            __builtin_amdgcn_fence(__ATOMIC_RELEASE, "agent");
            asm volatile("s_waitcnt vmcnt(0)" ::: "memory");
            const unsigned og = xb_add(&bar[XB_TOP], 1u);
            const unsigned tg = og / nx;
            if (og + 1u == (tg + 1u) * nx) xb_add(&bar[XB_TOPGEN], 1u);
            else XB_SPIN(xb_ld(&bar[XB_TOPGEN]) == tg, bar);
            __builtin_amdgcn_fence(__ATOMIC_ACQUIRE, "agent");
            xb_add(&bar[XB_XGEN(b.x)], 1u);
            asm volatile("s_waitcnt vmcnt(0)" ::: "memory");
        } else {
            XB_SPIN(xb_ld(&bar[XB_XGEN(b.x)]) == gen, bar);
            __builtin_amdgcn_fence(__ATOMIC_ACQUIRE, "agent");
            asm volatile("s_waitcnt vmcnt(0)" ::: "memory");
        }
    }
    __syncthreads();
}

constexpr int N_PHASES_K = 18;
__global__ void __launch_bounds__(NTHREADS, 2) fwd_megakernel(Params p_unused) {
    extern __shared__ __attribute__((aligned(16))) unsigned char lds[];
    LAS unsigned char* ldsl = (LAS unsigned char*)lds;
    float* ldsf = (float*)lds;
    cg::grid_group grid = cg::this_grid();
    const int lo = params_ptr()->ph_lo, hi = params_ptr()->ph_hi;
    const int G = gridDim.x, bx = blockIdx.x;
    int ph = 0;
    volatile LAS unsigned* xbst = (volatile LAS unsigned*)(ldsl + XB_LDS_OFF);
    if (threadIdx.x < 4) xbst[threadIdx.x] = 0u;
    __syncthreads();
    XcdBarrier xbar; xbar.bar = (unsigned*)(params_ptr()->ws + WS_BAR); xbar.x = 0; xbar.st = xbst;
    if (hi - lo > 1) xbar = xcd_barrier_post((unsigned*)(params_ptr()->ws + WS_BAR), xbst);
    const bool fusefin = (G == 256) && (hi - lo == N_PHASES_K);
#define SEAM() do { if (lo <= ph && ph + 1 < hi && !(fusefin && ph == N_PHASES_K - 2)) { if (hi > N_PHASES_K) grid.sync(); else xcd_barrier(xbar); } ++ph; } while (0)
#define RUN (lo <= ph && ph < hi)
#define WSP(off) ((bf16_t*)(q->ws + (off)))
    if (RUN) phase_prep(ldsf);
    SEAM();
#pragma unroll 1
    for (int l = 0; l < 4; ++l) {
        const int j = l >> 1; const bool ssm = (l & 1);
        const size_t wofs = ssm ? WS_WSSM + j * W_SSM_SZ : WS_W + j * W_POOL_SZ;
        if (RUN) { const ParamsPtr q = params_ptr(); pg8::Gemm g{WSP(WS_HBF), WSP(wofs), M_TOK, DE2, DM, 2u * DM, 32u, 128u, 0}; pg8::StaticOrder S; S.init(M_TOK, DE2, G, bx);
            pg8::EpiIn E{WSP(WS_UZ), (const float*)(q->ws + WS_ROWSS) + l * M_TOK, ssm ? WSP(WS_GATED) : nullptr}; pg8::gemm_phase<pg8::EpiIn>(ldsl, g, S, E); }
        SEAM();
        if (!ssm) {
            if (RUN) phase_pool();
            SEAM();
            if (RUN) { const ParamsPtr q = params_ptr(); pg8::Gemm g{WSP(WS_PG), WSP(wofs + W_POOL_GRP), M_TOK, DE, 1024, 2u * DE, 32u, 128u, 1}; pg8::StaticOrder S; S.init(M_TOK, DE, G, bx);
                pg8::EpiPool E{WSP(WS_GATED), WSP(WS_UZ) + DE, q->in[5] + (size_t)j * DE}; pg8::gemm_phase<pg8::EpiPool>(ldsl, g, S, E); }
            SEAM();
        } else {
            if (RUN) phase_ssm(j, lds);
            SEAM();
            if (RUN) { const ParamsPtr q = params_ptr(); pg8::Gemm g{WSP(WS_PG), WSP(wofs + W_SSM_GLU), M_TOK, DE, DE, 32u, 2u * GSTR, 8u * GSTR, 0}; pg8::StaticOrder S; S.init(M_TOK, DE, G, bx);
                pg8::EpiGlu E{WSP(WS_GATED), WSP(WS_UZ) + DE, WSP(WS_PG), q->in[17] + (size_t)j * DE}; pg8::gemm_phase<pg8::EpiGlu>(ldsl, g, S, E); }
            SEAM();
        }
        if (RUN && fusefin && l == 3) { const ParamsPtr q = params_ptr(); pg8::Gemm g{WSP(WS_GATED), WSP(wofs + W_SSM_OUT), M_TOK, DM, DE, 2u * DE, 32u, 128u, 0}; pg8::StaticOrder S; S.init(M_TOK, DM, G, bx);
            pg8::EpiOutFinal E{(const float*)q->out, q->out, q->in[2], (float*)(q->ws + WS_ROWSS) + 4 * M_TOK, (unsigned*)(q->ws + WS_PCNT)}; pg8::gemm_phase<pg8::EpiOutFinal>(ldsl, g, S, E); }
        else if (RUN) { const ParamsPtr q = params_ptr(); pg8::Gemm g{WSP(WS_GATED), WSP(wofs + (ssm ? W_SSM_OUT : W_POOL_OUT)), M_TOK, DM, DE, 2u * DE, 32u, 128u, 0}; pg8::StaticOrder S; S.init(M_TOK, DM, G, bx);
            pg8::EpiOut E{(l == 0) ? q->in[0] : (const float*)q->out, q->out, (l < 3) ? WSP(WS_HBF) : nullptr, q->in[1] + (size_t)(l < 3 ? l + 1 : 0) * DM, (float*)(q->ws + WS_ROWSS) + (l + 1) * M_TOK}; pg8::gemm_phase<pg8::EpiOut>(ldsl, g, S, E); }
        SEAM();
    }
    if (RUN && !fusefin) phase_final();
#undef SEAM
#undef RUN
#undef WSP
}
constexpr int N_PHASES = 18;

extern "C" void kernel_launch(void* const* d_in, const int* in_sizes, int n_in, void* d_out, int out_size, void* d_ws, size_t ws_size, hipStream_t stream) {
    static int grid = 0;
    if (grid == 0) {
        if (n_in != 19 || out_size != M_TOK * DM || ws_size < WS_END) { fprintf(stderr, "kernel_launch: unexpected shapes (n_in %d out %d ws %zu need %zu)\n", n_in, out_size, ws_size, (size_t)WS_END); grid = -1; return; }
        int dev = 0, cus = 0, per_cu = 0;
        hipGetDevice(&dev); hipDeviceGetAttribute(&cus, hipDeviceAttributeMultiprocessorCount, dev);
        if (hipFuncSetAttribute((const void*)fwd_megakernel, hipFuncAttributeMaxDynamicSharedMemorySize, LDS_BYTES) != hipSuccess) { fprintf(stderr, "kernel_launch: hipFuncSetAttribute failed\n"); grid = -1; return; }
        hipOccupancyMaxActiveBlocksPerMultiprocessor(&per_cu, (const void*)fwd_megakernel, NTHREADS, LDS_BYTES);
        if (per_cu < 1) { fprintf(stderr, "kernel_launch: occupancy query says %d blocks per CU\n", per_cu); per_cu = 1; }
        (void)hipGetLastError();
        grid = cus;
    }
    if (grid < 0) return;
    Params p{};
    for (int i = 0; i < 19; ++i) p.in[i] = (const float*)d_in[i];
    p.out = (float*)d_out; p.ws = (unsigned char*)d_ws;
#if ONE_LAUNCH
    p.ph_lo = 0; p.ph_hi = N_PHASES;
    if (hipMemsetAsync((char*)d_ws + WS_BAR, 0, 16 * 1024 + 32 * 256, stream) != hipSuccess) { fprintf(stderr, "kernel_launch: memset of barrier words failed\n"); return; }
    void* args[] = {&p};
    hipError_t e = hipLaunchCooperativeKernel((const void*)fwd_megakernel, dim3(grid), dim3(NTHREADS), args, LDS_BYTES, stream);
    if (e != hipSuccess) fprintf(stderr, "cooperative launch failed: %s (grid %d)\n", hipGetErrorString(e), grid);
#else
    for (int ph = 0; ph < N_PHASES; ++ph) { p.ph_lo = ph; p.ph_hi = ph + 1;
        hipLaunchKernelGGL(fwd_megakernel, dim3(grid), dim3(NTHREADS), LDS_BYTES, stream, p); }
#endif
}
```

```cpp
#include <hip/hip_runtime.h>
#include <hip/hip_cooperative_groups.h>
#include <cstdio>
namespace cg = cooperative_groups;

#ifndef ONE_LAUNCH
#define ONE_LAUNCH 1
#endif

#define LAS __attribute__((address_space(3)))
typedef unsigned short bf16_t;
typedef short bf16x8 __attribute__((ext_vector_type(8)));
typedef float f32x4 __attribute__((ext_vector_type(4)));
typedef float f32x2 __attribute__((ext_vector_type(2)));
typedef unsigned u32x4 __attribute__((ext_vector_type(4)));
typedef unsigned u32x2 __attribute__((ext_vector_type(2)));

constexpr int M_TOK = 8192, SEQ = 4096, DM = 2048, DE = 4096, DE2 = 8192;
constexpr int NG = 256, NS = 64, NP = 16, TCH = 16, NCH = SEQ / TCH;
constexpr float EPS = 1e-6f;
constexpr int NTHREADS = 512;
constexpr int GSTR = M_TOK * 16 + 2176;
constexpr int HSTR = 2 * (SEQ / 16) * 128 + 1088;
constexpr int LDS_BYTES = 163840;
constexpr int XB_LDS_OFF = LDS_BYTES - 64;

constexpr size_t MiB = 1024 * 1024;
constexpr size_t WS_HBF = 0;
constexpr size_t WS_UZ = WS_HBF + 34 * MiB;
constexpr size_t WS_PG = WS_UZ + 128 * MiB;
constexpr size_t WS_GATED = WS_PG + 66 * MiB;
constexpr size_t WS_W = WS_GATED + 66 * MiB;
constexpr size_t W_POOL_IN = 0, W_POOL_GRP = 32 * MiB, W_POOL_OUT = 40 * MiB, W_POOL_SZ = 56 * MiB;
constexpr size_t W_SSM_IN = 0, W_SSM_GLU = 32 * MiB, W_SSM_OUT = 64 * MiB, W_SSM_SZ = 80 * MiB;
constexpr size_t WS_WSSM = WS_W + 2 * W_POOL_SZ;
constexpr size_t WS_ROWSS = WS_WSSM + 2 * W_SSM_SZ;
constexpr size_t WS_BAR = WS_ROWSS + 512 * 1024;
constexpr size_t WS_PCNT = WS_BAR + 16 * 1024;
constexpr size_t WS_END = WS_ROWSS + 1 * MiB;

struct Params {
    const float* in[19];
    float* out;
    unsigned char* ws;
    int ph_lo, ph_hi;
};

typedef const __attribute__((address_space(4))) Params* ParamsPtr;
__device__ __forceinline__ ParamsPtr params_ptr() { ParamsPtr q = (ParamsPtr)__builtin_amdgcn_kernarg_segment_ptr(); asm volatile("" : "+s"(q)); return q; }
__device__ __forceinline__ int fresh_tid() { int t = threadIdx.x; asm volatile("" : "+v"(t)); return t; }

__device__ __forceinline__ unsigned cvt_pk_bf16(float lo, float hi) { unsigned r; asm volatile("v_cvt_pk_bf16_f32 %0, %1, %2" : "=v"(r) : "v"(lo), "v"(hi)); return r; }
__device__ __forceinline__ float bf_lo(unsigned w) { return __uint_as_float(w << 16); }
__device__ __forceinline__ float bf_hi(unsigned w) { return __uint_as_float(w & 0xffff0000u); }
__device__ __forceinline__ float bf2f(bf16_t b) { return __uint_as_float(((unsigned)b) << 16); }
__device__ __forceinline__ float fast_rcp(float x) { return __builtin_amdgcn_rcpf(x); }
__device__ __forceinline__ float silu_f(float z) { return z * fast_rcp(1.0f + __builtin_amdgcn_exp2f(z * -1.44269504f)); }
__device__ __forceinline__ float sigmoid_f(float z) { return fast_rcp(1.0f + __expf(-z)); }
__device__ __forceinline__ float gelu_tanh_f(float y) {
    const float t = __builtin_amdgcn_exp2f(y * __builtin_fmaf(-0.10294324f, y * y, -2.3022082f));
    return y * fast_rcp(1.0f + t);
}
__device__ __forceinline__ float glu_gate_f(float g, float v, float z) {
    const float ev = __builtin_amdgcn_exp2f(v * -1.44269504f), ez = __builtin_amdgcn_exp2f(z * -1.44269504f);
    return g * z * fast_rcp((1.0f + ev) * (1.0f + ez));
}

namespace pg8 {
constexpr int BM = 256, BK = 64, HALF = 128, HTB = HALF * BK * 2, STAGE_BYTES = 8 * HTB, NXCD = 8, WGM = 8;
__host__ __device__ __forceinline__ int lds_byte(int r, int c) { const int st = (r >> 4) * 2 + (c >> 5), rr = r & 15, cc = c & 31, ob = rr * 64 + cc * 2; return st * 1024 + (ob ^ (((ob >> 9) & 1) << 5)); }
__host__ __device__ __forceinline__ void stage_rc(int b, int& R, int& C) { const int st = b / 1024, sb = b % 1024, swz = sb ^ (((sb >> 9) & 1) << 5); R = (st >> 1) * 16 + swz / 64; C = (st & 1) * 32 + (swz % 64) / 2; }
__host__ __device__ __forceinline__ int perm32(int rho) { const int n = rho >> 4, i = rho & 15; return 8 * (i >> 2) + 4 * n + (i & 3); }

struct Unit { int pm, pn; };
struct Gemm { const bf16_t* A; const bf16_t* Bt; int M, N, K; unsigned a_row, a_c16, a_kt; int grouped; };

struct StaticOrder {
    int nM, nN, nwg, G, c;
    __device__ void init(int M, int N, int G_, int c_) { nM = M / BM; nN = N / BM; nwg = nM * nN; G = G_; c = c_; }
    __device__ bool next(int i, Unit& u) const {
        const long L = (long)i * G + c; if (L >= nwg) return false;
        int wgid = (int)L; { const int q = nwg / NXCD, r = nwg % NXCD, xcd = wgid % NXCD, off = wgid / NXCD; wgid = (xcd < r ? xcd * (q + 1) : r * (q + 1) + (xcd - r) * q) + off; }
        const int nig = WGM * nN, gid = wgid / nig, fm = gid * WGM, gsz = (nM - fm) < WGM ? (nM - fm) : WGM;
        u.pm = fm + ((wgid % nig) % gsz); u.pn = (wgid % nig) / gsz; return true;
    }
};

template <class Epi>
__device__ __forceinline__ void gemm_phase(LAS unsigned char* lds, const Gemm g, const StaticOrder& S, const Epi& E) {
    const int tid = fresh_tid(), wid = __builtin_amdgcn_readfirstlane(tid >> 6), lane = tid & 63, wr = wid >> 2, wc = wid & 3, fr = lane & 15, fq = lane >> 4;
    const int K = g.K, nt = K / BK;
    unsigned voffA[2], voffB[2];
#pragma unroll
    for (int i = 0; i < 2; ++i) { int R, C; stage_rc(tid * 16 + i * 8192, R, C); const int Rb = Epi::PERM ? ((R & ~31) + perm32(R & 31)) : R;
        voffA[i] = (unsigned)R * g.a_row + (unsigned)(C >> 4) * g.a_c16 + (unsigned)(C & 15) * 2u; voffB[i] = (unsigned)(Rb * K + C) * 2u; }
    const size_t kstep = (size_t)(BK * 2), kstepA = (size_t)g.a_kt;
    const size_t hstepA = (size_t)HALF * g.a_row, hstepB = (size_t)HALF * K * 2;
    const size_t tstepA = 2 * hstepA, tstepB = 2 * hstepB;
    const size_t gstepA = g.grouped ? (size_t)K * 2 : 0;
    const unsigned ldsw = (unsigned)wid * 1024u;
    const int aoff = lds_byte(wr * 64 + fr, fq * 8), boff = lds_byte(wc * 32 + fr, fq * 8);
#define PG8_SA(b, h) (((b) * 2 + (h)) * HTB)
#define PG8_SB(b, h) ((4 + (b) * 2 + (h)) * HTB)
#define PG8_STAGE(bufoff, gbase, voff) do { _Pragma("unroll") for (int _i = 0; _i < 2; ++_i) \
        __builtin_amdgcn_global_load_lds((const unsigned*)((const char*)(gbase) + (voff)[_i]), (LAS unsigned*)(lds + (bufoff) + ldsw + _i * 8192), 16, 0, 0); } while (0)
#define PG8_LDA(dst, b, h) do { _Pragma("unroll") for (int m = 0; m < 4; ++m) _Pragma("unroll") for (int k = 0; k < 2; ++k) dst[m][k] = *(const LAS bf16x8*)(lds + PG8_SA(b, h) + aoff + m * 2048 + k * 1024); } while (0)
#define PG8_LDB(dst, b, h) do { _Pragma("unroll") for (int n = 0; n < 2; ++n) _Pragma("unroll") for (int k = 0; k < 2; ++k) dst[n][k] = *(const LAS bf16x8*)(lds + PG8_SB(b, h) + boff + n * 2048 + k * 1024); } while (0)
#define PG8_MMA(ai, bj, At, Bt) do { __builtin_amdgcn_s_setprio(1); _Pragma("unroll") for (int m = 0; m < 4; ++m) _Pragma("unroll") for (int n = 0; n < 2; ++n) _Pragma("unroll") for (int k = 0; k < 2; ++k) \
        acc[ai][bj][m][n] = __builtin_amdgcn_mfma_f32_16x16x32_bf16(Bt[n][k], At[m][k], acc[ai][bj][m][n], 0, 0, 0); __builtin_amdgcn_s_setprio(0); } while (0)
#define PG8_WAIT_V(n) asm volatile("s_waitcnt vmcnt(" #n ")" ::: "memory")
#define PG8_WAIT_L(n) asm volatile("s_waitcnt lgkmcnt(" #n ")" ::: "memory")
#define PG8_BAR __builtin_amdgcn_s_barrier()
#define PG8_SCHED __builtin_amdgcn_sched_barrier(0)
    Unit cur, nxt; int ui = 0;
    if (!S.next(0, cur)) return;
    typename Epi::Pre pre = E.pre(cur, wr, fr);
    f32x4 acc[2][2][4][2];
#pragma unroll
    for (int a = 0; a < 2; ++a)
#pragma unroll
        for (int b = 0; b < 2; ++b)
#pragma unroll
            for (int m = 0; m < 4; ++m)
#pragma unroll
                for (int n = 0; n < 2; ++n) acc[a][b][m][n] = (f32x4){0.f, 0.f, 0.f, 0.f};
    bf16x8 At[4][2], B0[2][2], B1[2][2];
    const char* cA = (const char*)g.A + (size_t)cur.pm * tstepA + (size_t)(cur.pn >> 2) * gstepA; const char* cB = (const char*)g.Bt + (size_t)cur.pn * tstepB;
    PG8_STAGE(PG8_SB(0, 0), cB, voffB); PG8_STAGE(PG8_SA(0, 0), cA, voffA); PG8_STAGE(PG8_SB(0, 1), cB + hstepB, voffB); PG8_STAGE(PG8_SA(0, 1), cA + hstepA, voffA);
    if (wr == 1) PG8_BAR;
    PG8_WAIT_V(4); PG8_BAR;
    PG8_STAGE(PG8_SB(1, 0), cB + kstep, voffB); PG8_STAGE(PG8_SA(1, 0), cA + kstepA, voffA); PG8_STAGE(PG8_SB(1, 1), cB + hstepB + kstep, voffB);
    PG8_WAIT_V(6); PG8_BAR;
    for (;;) {
        const bool has_next = S.next(ui + 1, nxt);
        const char* nA = has_next ? (const char*)g.A + (size_t)nxt.pm * tstepA + (size_t)(nxt.pn >> 2) * gstepA : cA; const char* nB = has_next ? (const char*)g.Bt + (size_t)nxt.pn * tstepB : cB;
        for (int t = 0; t < nt; t += 2) {
            const bool last = (t == nt - 2);
            const char* a1 = cA + (size_t)(t + 1) * kstepA;
            const char* a2 = last ? nA : cA + (size_t)(t + 2) * kstepA; const char* b2 = last ? nB : cB + (size_t)(t + 2) * kstep;
            const char* a3 = a2 + kstepA; const char* b3 = b2 + kstep;
            PG8_LDB(B0, 0, 0); PG8_SCHED; PG8_LDA(At, 0, 0); PG8_STAGE(PG8_SA(1, 1), a1 + hstepA, voffA);
            PG8_WAIT_L(8); PG8_BAR; PG8_WAIT_L(0); PG8_MMA(0, 0, At, B0); PG8_BAR; PG8_SCHED;
            PG8_LDB(B1, 0, 1); PG8_STAGE(PG8_SB(0, 0), b2, voffB);
            PG8_BAR; PG8_WAIT_L(0); PG8_MMA(0, 1, At, B1); PG8_BAR;
            PG8_LDA(At, 0, 1); PG8_STAGE(PG8_SA(0, 0), a2, voffA);
            PG8_BAR; PG8_WAIT_L(0); PG8_MMA(1, 0, At, B0); PG8_BAR; PG8_SCHED;
            PG8_STAGE(PG8_SB(0, 1), b2 + hstepB, voffB);
            PG8_WAIT_V(6); PG8_BAR; PG8_MMA(1, 1, At, B1); PG8_BAR;
            PG8_LDB(B0, 1, 0); PG8_SCHED; PG8_LDA(At, 1, 0); PG8_STAGE(PG8_SA(0, 1), a2 + hstepA, voffA);
            PG8_WAIT_L(8); PG8_BAR; PG8_WAIT_L(0); PG8_MMA(0, 0, At, B0); PG8_BAR; PG8_SCHED;
            PG8_LDB(B1, 1, 1); PG8_STAGE(PG8_SB(1, 0), b3, voffB);
            PG8_BAR; PG8_WAIT_L(0); PG8_MMA(0, 1, At, B1); PG8_BAR;
            PG8_LDA(At, 1, 1); PG8_STAGE(PG8_SA(1, 0), a3, voffA);
            PG8_BAR; PG8_WAIT_L(0); PG8_MMA(1, 0, At, B0); PG8_BAR; PG8_SCHED;
            PG8_STAGE(PG8_SB(1, 1), b3 + hstepB, voffB);
            PG8_WAIT_V(6); PG8_BAR; PG8_MMA(1, 1, At, B1); PG8_BAR;
        }
        if constexpr (!Epi::AFTER_DRAIN) E(acc, cur, wr, wc, fr, fq, pre);
        if (!has_next) break;
#pragma unroll
        for (int a = 0; a < 2; ++a)
#pragma unroll
            for (int b = 0; b < 2; ++b)
#pragma unroll
                for (int m = 0; m < 4; ++m)
#pragma unroll
                    for (int n = 0; n < 2; ++n) acc[a][b][m][n] = (f32x4){0.f, 0.f, 0.f, 0.f};
        cur = nxt; cA = nA; cB = nB; ++ui;
        pre = E.pre(cur, wr, fr);
    }
    PG8_WAIT_V(0);
    if (wr == 0) PG8_BAR;
    PG8_BAR;
    if constexpr (Epi::AFTER_DRAIN) E.fused(acc, cur, wr, wc, fr, fq);
#undef PG8_SA
#undef PG8_SB
#undef PG8_STAGE
#undef PG8_LDA
#undef PG8_LDB
#undef PG8_MMA
#undef PG8_WAIT_V
#undef PG8_WAIT_L
#undef PG8_BAR
#undef PG8_SCHED
}

struct EpiIn {
    static constexpr bool AFTER_DRAIN = false;
    static constexpr bool PERM = true;
    bf16_t* O; const float* rowss; bf16_t* UG;
    struct Pre { float rs[8]; };
    __device__ __forceinline__ Pre pre(const Unit& u, int wr, int fr) const { Pre p; const int row0 = u.pm * BM + wr * 64 + fr;
#pragma unroll
        for (int g8 = 0; g8 < 8; ++g8) p.rs[g8] = rowss[row0 + (g8 >> 2) * HALF + (g8 & 3) * 16];
        return p; }
    __device__ __forceinline__ void operator()(const f32x4 (&acc)[2][2][4][2], const Unit& u, int wr, int wc, int fr, int fq, const Pre& pp) const {
        const int row0 = u.pm * BM + wr * 64 + fr, col0 = u.pn * BM + wc * 32 + 8 * fq;
        const bool gm = (UG != nullptr) && (u.pn < DE / BM);
        const float (&rs)[8] = pp.rs;
#pragma unroll
        for (int ai = 0; ai < 2; ++ai)
#pragma unroll
            for (int m = 0; m < 4; ++m) { const int r = row0 + ai * HALF + m * 16; const float inv = rsqrtf(rs[ai * 4 + m] * (1.0f / DM) + EPS);
#pragma unroll
                for (int bj = 0; bj < 2; ++bj) { const f32x4 v0 = acc[ai][bj][m][0] * inv, v1 = acc[ai][bj][m][1] * inv; const int c = col0 + bj * HALF;
                    u32x4 w; w.x = cvt_pk_bf16(v0[0], v0[1]); w.y = cvt_pk_bf16(v0[2], v0[3]); w.z = cvt_pk_bf16(v1[0], v1[1]); w.w = cvt_pk_bf16(v1[2], v1[3]);
                    bf16_t* dst = gm ? UG + (size_t)(c >> 4) * GSTR + r * 16 + (c & 15) : O + (size_t)r * DE2 + c;
                    *(u32x4*)dst = w; } }
    }
};
struct EpiPool {
    static constexpr bool AFTER_DRAIN = false;
    static constexpr bool PERM = true;
    bf16_t* O; const bf16_t* Z; const float* scale;
    struct Pre {};
    __device__ __forceinline__ Pre pre(const Unit&, int, int) const { return Pre{}; }
    __device__ __forceinline__ void operator()(const f32x4 (&acc)[2][2][4][2], const Unit& u, int wr, int wc, int fr, int fq, const Pre&) const {
        const int row0 = u.pm * BM + wr * 64 + fr, col0 = u.pn * BM + wc * 32 + 8 * fq;
        f32x4 sc[2][2];
#pragma unroll
        for (int bj = 0; bj < 2; ++bj) { sc[bj][0] = *(const f32x4*)(scale + col0 + bj * HALF); sc[bj][1] = *(const f32x4*)(scale + col0 + bj * HALF + 4); }
#pragma unroll
        for (int bj = 0; bj < 2; ++bj) { const int c = col0 + bj * HALF;
            u32x4 zv[8];
#pragma unroll
            for (int g8 = 0; g8 < 8; ++g8) zv[g8] = *(const u32x4*)(Z + (size_t)(row0 + (g8 >> 2) * HALF + (g8 & 3) * 16) * DE2 + c);
#pragma unroll
            for (int ai = 0; ai < 2; ++ai)
#pragma unroll
                for (int m = 0; m < 4; ++m) { const int r = row0 + ai * HALF + m * 16;
                    const u32x4 zw = zv[ai * 4 + m];
                    const f32x4 a0 = acc[ai][bj][m][0] * sc[bj][0], a1 = acc[ai][bj][m][1] * sc[bj][1];
                    u32x4 w;
                    w.x = cvt_pk_bf16(a0[0] * silu_f(bf_lo(zw.x)), a0[1] * silu_f(bf_hi(zw.x)));
                    w.y = cvt_pk_bf16(a0[2] * silu_f(bf_lo(zw.y)), a0[3] * silu_f(bf_hi(zw.y)));
                    w.z = cvt_pk_bf16(a1[0] * silu_f(bf_lo(zw.z)), a1[1] * silu_f(bf_hi(zw.z)));
                    w.w = cvt_pk_bf16(a1[2] * silu_f(bf_lo(zw.w)), a1[3] * silu_f(bf_hi(zw.w)));
                    *(u32x4*)(O + (size_t)r * DE + c) = w; } }
    }
};
struct EpiGlu {
    static constexpr bool AFTER_DRAIN = false;
    static constexpr bool PERM = true;
    bf16_t* O; const bf16_t* Z; const bf16_t* Gm; const float* bias;
    struct Pre {};
    __device__ __forceinline__ Pre pre(const Unit&, int, int) const { return Pre{}; }
    __device__ __forceinline__ void operator()(const f32x4 (&acc)[2][2][4][2], const Unit& u, int wr, int wc, int fr, int fq, const Pre&) const {
        const int row0 = u.pm * BM + wr * 64 + fr, col0 = u.pn * BM + wc * 32 + 8 * fq;
        f32x4 bs[2][2];
#pragma unroll
        for (int bj = 0; bj < 2; ++bj) { bs[bj][0] = *(const f32x4*)(bias + col0 + bj * HALF); bs[bj][1] = *(const f32x4*)(bias + col0 + bj * HALF + 4); }
#pragma unroll
        for (int bj = 0; bj < 2; ++bj) { const int c = col0 + bj * HALF;
#pragma unroll
            for (int ai = 0; ai < 2; ++ai) { u32x4 zv[4], gv[4];
#pragma unroll
                for (int m = 0; m < 4; ++m) { const int r = row0 + ai * HALF + m * 16; zv[m] = *(const u32x4*)(Z + (size_t)r * DE2 + c); gv[m] = *(const u32x4*)(Gm + (size_t)(c >> 4) * GSTR + r * 16 + (c & 15)); }
#pragma unroll
                for (int m = 0; m < 4; ++m) { const int r = row0 + ai * HALF + m * 16;
                    const u32x4 zw = zv[m], gw = gv[m];
                    const f32x4 a0 = acc[ai][bj][m][0] + bs[bj][0], a1 = acc[ai][bj][m][1] + bs[bj][1];
                    u32x4 w;
                    w.x = cvt_pk_bf16(glu_gate_f(bf_lo(gw.x), a0[0], bf_lo(zw.x)), glu_gate_f(bf_hi(gw.x), a0[1], bf_hi(zw.x)));
                    w.y = cvt_pk_bf16(glu_gate_f(bf_lo(gw.y), a0[2], bf_lo(zw.y)), glu_gate_f(bf_hi(gw.y), a0[3], bf_hi(zw.y)));
                    w.z = cvt_pk_bf16(glu_gate_f(bf_lo(gw.z), a1[0], bf_lo(zw.z)), glu_gate_f(bf_hi(gw.z), a1[1], bf_hi(zw.z)));
                    w.w = cvt_pk_bf16(glu_gate_f(bf_lo(gw.w), a1[2], bf_lo(zw.w)), glu_gate_f(bf_hi(gw.w), a1[3], bf_hi(zw.w)));
                    *(u32x4*)(O + (size_t)r * DE + c) = w; } } }
    }
};
struct EpiOut {
    static constexpr bool AFTER_DRAIN = false;
    static constexpr bool PERM = false;
    const float* Xin; float* X; bf16_t* H; const float* gnext; float* rowss_next;
    struct Pre {};
    __device__ __forceinline__ Pre pre(const Unit&, int, int) const { return Pre{}; }
    __device__ __forceinline__ void operator()(const f32x4 (&acc)[2][2][4][2], const Unit& u, int wr, int wc, int fr, int fq, const Pre&) const {
        const int row0 = u.pm * BM + wr * 64 + fr, col0 = u.pn * BM + wc * 32 + 4 * fq;
        f32x4 gv[2][2];
#pragma unroll
        for (int bj = 0; bj < 2; ++bj)
#pragma unroll
            for (int n = 0; n < 2; ++n) gv[bj][n] = *(const f32x4*)(gnext + col0 + bj * HALF + n * 16);
        f32x4 xb[2][2][2];
#pragma unroll
        for (int bj = 0; bj < 2; ++bj)
#pragma unroll
            for (int n = 0; n < 2; ++n) xb[0][bj][n] = *(const f32x4*)(Xin + (size_t)row0 * DM + col0 + bj * HALF + n * 16);
#pragma unroll
        for (int grp = 0; grp < 8; ++grp) { const int ai = grp >> 2, m = grp & 3, cur = grp & 1; const int r = row0 + ai * HALF + m * 16; float ss = 0.f;
            if (grp < 7) { const int rn = row0 + ((grp + 1) >> 2) * HALF + ((grp + 1) & 3) * 16;
#pragma unroll
                for (int bj = 0; bj < 2; ++bj)
#pragma unroll
                    for (int n = 0; n < 2; ++n) xb[cur ^ 1][bj][n] = *(const f32x4*)(Xin + (size_t)rn * DM + col0 + bj * HALF + n * 16); }
#pragma unroll
            for (int bj = 0; bj < 2; ++bj)
#pragma unroll
                for (int n = 0; n < 2; ++n) { const int c = col0 + bj * HALF + n * 16;
                    const f32x4 xv = xb[cur][bj][n] + acc[ai][bj][m][n]; __builtin_nontemporal_store(xv, (f32x4*)(X + (size_t)r * DM + c));
                    ss += (xv[0] * xv[0] + xv[1] * xv[1]) + (xv[2] * xv[2] + xv[3] * xv[3]);
                    if (H) { const f32x4 hv = xv * gv[bj][n]; u32x2 w; w.x = cvt_pk_bf16(hv[0], hv[1]); w.y = cvt_pk_bf16(hv[2], hv[3]);
                        *(u32x2*)(H + (size_t)r * DM + c) = w; } }
            ss += __shfl_xor(ss, 16); ss += __shfl_xor(ss, 32);
            if (fq == 0) atomicAdd(rowss_next + r, ss); }
    }
};
struct EpiOutFinal {
    static constexpr bool AFTER_DRAIN = true;
    static constexpr bool PERM = false;
    const float* Xin; float* Out; const float* gfin; float* rowss; unsigned* cnt;
    struct Pre {};
    __device__ __forceinline__ Pre pre(const Unit&, int, int) const { return Pre{}; }
    __device__ __forceinline__ void fused(f32x4 (&acc)[2][2][4][2], const Unit& u, int wr, int wc, int fr, int fq) const {
        const int row0 = u.pm * BM + wr * 64 + fr, col0 = u.pn * BM + wc * 32 + 4 * fq;
        f32x4 xb[2][2][2];
#pragma unroll
        for (int bj = 0; bj < 2; ++bj)
#pragma unroll
            for (int n = 0; n < 2; ++n) xb[0][bj][n] = *(const f32x4*)(Xin + (size_t)row0 * DM + col0 + bj * HALF + n * 16);
#pragma unroll
        for (int grp = 0; grp < 8; ++grp) { const int ai = grp >> 2, m = grp & 3, cur = grp & 1; const int r = row0 + ai * HALF + m * 16; float ss = 0.f;
            if (grp < 7) { const int rn = row0 + ((grp + 1) >> 2) * HALF + ((grp + 1) & 3) * 16;
#pragma unroll
                for (int bj = 0; bj < 2; ++bj)
#pragma unroll
                    for (int n = 0; n < 2; ++n) xb[cur ^ 1][bj][n] = *(const f32x4*)(Xin + (size_t)rn * DM + col0 + bj * HALF + n * 16); }
#pragma unroll
            for (int bj = 0; bj < 2; ++bj)
#pragma unroll
                for (int n = 0; n < 2; ++n) { const f32x4 xv = xb[cur][bj][n] + acc[ai][bj][m][n]; acc[ai][bj][m][n] = xv;
                    ss += (xv[0] * xv[0] + xv[1] * xv[1]) + (xv[2] * xv[2] + xv[3] * xv[3]); }
            ss += __shfl_xor(ss, 16); ss += __shfl_xor(ss, 32);
            if (fq == 0) atomicAdd(rowss + r, ss); }
        asm volatile("s_waitcnt vmcnt(0)" ::: "memory");
        __syncthreads();
        if (threadIdx.x == 0) { unsigned* c = cnt + 64 * u.pm;
            __hip_atomic_fetch_add(c, 1u, __ATOMIC_RELAXED, __HIP_MEMORY_SCOPE_AGENT);
            unsigned sp = 0;
            while (__hip_atomic_load(c, __ATOMIC_RELAXED, __HIP_MEMORY_SCOPE_AGENT) < 8u) { __builtin_amdgcn_s_sleep(2); if (++sp > (1u << 22)) break; } }
        __syncthreads();
        f32x4 gv[2][2]; float rs[8];
#pragma unroll
        for (int bj = 0; bj < 2; ++bj)
#pragma unroll
            for (int n = 0; n < 2; ++n) gv[bj][n] = *(const f32x4*)(gfin + col0 + bj * HALF + n * 16);
#pragma unroll
        for (int g8 = 0; g8 < 8; ++g8) rs[g8] = __hip_atomic_load(rowss + row0 + (g8 >> 2) * HALF + (g8 & 3) * 16, __ATOMIC_RELAXED, __HIP_MEMORY_SCOPE_AGENT);
#pragma unroll
        for (int ai = 0; ai < 2; ++ai)
#pragma unroll
            for (int m = 0; m < 4; ++m) { const int r = row0 + ai * HALF + m * 16; const float inv = rsqrtf(rs[ai * 4 + m] * (1.0f / DM) + EPS);
#pragma unroll
                for (int bj = 0; bj < 2; ++bj)
#pragma unroll
                    for (int n = 0; n < 2; ++n) *(f32x4*)(Out + (size_t)r * DM + col0 + bj * HALF + n * 16) = acc[ai][bj][m][n] * inv * gv[bj][n]; }
    }
};
}

#define LDS_BARRIER() asm volatile("s_waitcnt lgkmcnt(0)\n\ts_barrier" ::: "memory")
struct CvtJob { const float* src; bf16_t* dst; int K, N, k0, n0; };
constexpr int N_CVT_TILES_K = 2 * 4352;
__device__ __forceinline__ CvtJob cvt_decode(int t, const ParamsPtr pq) {
    t = N_CVT_TILES_K - 1 - t;
    CvtJob J; const int jj = t / 4352; int r = t % 4352; unsigned char* ws = pq->ws;
    if (r < 1792) { bf16_t* wp = (bf16_t*)(ws + WS_W + jj * W_POOL_SZ);
        if (r < 1024) { J.src = pq->in[3] + (size_t)jj * DM * DE2; J.dst = wp + W_POOL_IN / 2; J.K = DM; J.N = DE2; }
        else if (r < 1280) { r -= 1024; const int g = r >> 6; r &= 63; J.src = pq->in[4] + ((size_t)jj * 4 + g) * 1024 * 1024; J.dst = wp + W_POOL_GRP / 2 + (size_t)g * 1024 * 1024; J.K = 1024; J.N = 1024; }
        else { r -= 1280; J.src = pq->in[6] + (size_t)jj * DE * DM; J.dst = wp + W_POOL_OUT / 2; J.K = DE; J.N = DM; }
    } else { r -= 1792; bf16_t* wp = (bf16_t*)(ws + WS_WSSM + jj * W_SSM_SZ);
        if (r < 1024) { J.src = pq->in[7] + (size_t)jj * DM * DE2; J.dst = wp + W_SSM_IN / 2; J.K = DM; J.N = DE2; }
        else if (r < 2048) { r -= 1024; J.src = pq->in[16] + (size_t)jj * DE * DE; J.dst = wp + W_SSM_GLU / 2; J.K = DE; J.N = DE; }
        else { r -= 2048; J.src = pq->in[18] + (size_t)jj * DE * DM; J.dst = wp + W_SSM_OUT / 2; J.K = DE; J.N = DM; }
    }
    const int tn = J.N / 256; J.k0 = (r / tn) * 64; J.n0 = (r % tn) * 256; return J;
}
constexpr int N_CVT_TILES = 2 * 4352;
__device__ void convert_weights(float* tile) {
    const ParamsPtr pq = params_ptr();
    const int tid = fresh_tid(), rl = tid >> 6, c4 = (tid & 63) * 4;
    float4 cur[8];
    int t = blockIdx.x;
    if (t < N_CVT_TILES) { const CvtJob J = cvt_decode(t, pq);
#pragma unroll
        for (int ii = 0; ii < 8; ++ii) { const f32x4 t_ = __builtin_nontemporal_load((const f32x4*)(J.src + (size_t)(J.k0 + ii * 8 + rl) * J.N + J.n0 + c4)); cur[ii] = make_float4(t_[0], t_[1], t_[2], t_[3]); } }
    for (; t < N_CVT_TILES; t += gridDim.x) {
        const CvtJob J = cvt_decode(t, pq);
#pragma unroll
        for (int ii = 0; ii < 8; ++ii) { float* tp = tile + (ii * 8 + rl) * 257 + c4; tp[0] = cur[ii].x; tp[1] = cur[ii].y; tp[2] = cur[ii].z; tp[3] = cur[ii].w; }
        const int tn = t + gridDim.x;
        if (tn < N_CVT_TILES) { const CvtJob Jn = cvt_decode(tn, pq);
#pragma unroll
            for (int ii = 0; ii < 8; ++ii) { const f32x4 t_ = __builtin_nontemporal_load((const f32x4*)(Jn.src + (size_t)(Jn.k0 + ii * 8 + rl) * Jn.N + Jn.n0 + c4)); cur[ii] = make_float4(t_[0], t_[1], t_[2], t_[3]); } }
        LDS_BARRIER();
#pragma unroll
        for (int ii = 0; ii < 4; ++ii) { const int f = tid + 512 * ii, n = f >> 3, k8 = (f & 7) * 8; const float* tp = tile + k8 * 257 + n;
            u32x4 w; w.x = cvt_pk_bf16(tp[0], tp[257]); w.y = cvt_pk_bf16(tp[2 * 257], tp[3 * 257]); w.z = cvt_pk_bf16(tp[4 * 257], tp[5 * 257]); w.w = cvt_pk_bf16(tp[6 * 257], tp[7 * 257]);
            *(u32x4*)(J.dst + (size_t)(J.n0 + n) * J.K + J.k0 + k8) = w; }
        LDS_BARRIER();
    }
}

__device__ void phase_prep(float* ldsf) {
    const ParamsPtr pq = params_ptr(); Params p;
#pragma unroll
    for (int i = 0; i < 19; ++i) p.in[i] = pq->in[i];
    p.out = pq->out; p.ws = pq->ws; p.ph_lo = 0; p.ph_hi = 0;
    const int tid = fresh_tid(), lane = tid & 63, wave = tid >> 6;
    const float* x = p.in[0]; const float* g0 = p.in[1];
    bf16_t* hbf = (bf16_t*)(p.ws + WS_HBF); float* rowss = (float*)(p.ws + WS_ROWSS);
    for (int i = blockIdx.x * NTHREADS + tid; i < 4 * M_TOK; i += gridDim.x * NTHREADS) rowss[M_TOK + i] = 0.f;
    convert_weights(ldsf);
    float4 gq[8];
#pragma unroll
    for (int i = 0; i < 8; ++i) gq[i] = ((const float4*)g0)[i * 64 + lane];
    for (int row = blockIdx.x * 8 + wave; row < M_TOK; row += gridDim.x * 8) {
        const float4* xr = (const float4*)(x + (size_t)row * DM);
        float4 xv[8];
#pragma unroll
        for (int i = 0; i < 8; ++i) xv[i] = xr[i * 64 + lane];
        float ss = 0.f;
#pragma unroll
        for (int i = 0; i < 8; ++i) { const int idx = i * 64 + lane; const float4 v = xv[i];
            ss += (v.x * v.x + v.y * v.y) + (v.z * v.z + v.w * v.w);
            u32x2 w; w.x = cvt_pk_bf16(v.x * gq[i].x, v.y * gq[i].y); w.y = cvt_pk_bf16(v.z * gq[i].z, v.w * gq[i].w);
            *(u32x2*)(hbf + (size_t)row * DM + idx * 4) = w; }
#pragma unroll
        for (int o = 32; o >= 1; o >>= 1) ss += __shfl_xor(ss, o);
        if (lane == 0) rowss[row] = ss;
    }
}

__device__ void phase_pool() {
    const ParamsPtr p_ = params_ptr(); unsigned char* ws = p_->ws;
    const bf16_t* uz = (const bf16_t*)(ws + WS_UZ); bf16_t* pg = (bf16_t*)(ws + WS_PG);
    constexpr int RB = 32;
    for (int idx = blockIdx.x * NTHREADS + fresh_tid(); idx < (M_TOK / RB) * (DE / 8); idx += gridDim.x * NTHREADS) {
        const int c8 = idx % (DE / 8), rb = idx / (DE / 8), col = c8 * 8, g = col >> 10, w = 2 << g, row0 = rb * RB, tl0 = row0 & (SEQ - 1);
        float s[8];
#pragma unroll
        for (int i = 0; i < 8; ++i) s[i] = 0.f;
        const int nh = (tl0 < w) ? tl0 : w;
        { u32x4 hv[16];
#pragma unroll
          for (int k = 1; k <= 16; ++k) hv[k - 1] = (k <= nh) ? *(const u32x4*)(uz + (size_t)(row0 - k) * DE2 + col) : (u32x4){0u, 0u, 0u, 0u};
#pragma unroll
          for (int k = 0; k < 16; ++k) { const u32x4 v = hv[k];
            s[0] += bf_lo(v.x); s[1] += bf_hi(v.x); s[2] += bf_lo(v.y); s[3] += bf_hi(v.y); s[4] += bf_lo(v.z); s[5] += bf_hi(v.z); s[6] += bf_lo(v.w); s[7] += bf_hi(v.w); } }
#pragma unroll 1
        for (int r0 = 0; r0 < RB; r0 += 8) {
            u32x4 vv[8], ov[8];
#pragma unroll
            for (int k = 0; k < 8; ++k) { const int row = row0 + r0 + k, tl = tl0 + r0 + k;
                vv[k] = *(const u32x4*)(uz + (size_t)row * DE2 + col);
                ov[k] = (tl >= w) ? *(const u32x4*)(uz + (size_t)(row - w) * DE2 + col) : (u32x4){0u, 0u, 0u, 0u}; }
#pragma unroll
            for (int k = 0; k < 8; ++k) { const int row = row0 + r0 + k, tl = tl0 + r0 + k; const u32x4 v = vv[k], o2 = ov[k];
                s[0] += bf_lo(v.x) - bf_lo(o2.x); s[1] += bf_hi(v.x) - bf_hi(o2.x); s[2] += bf_lo(v.y) - bf_lo(o2.y); s[3] += bf_hi(v.y) - bf_hi(o2.y);
                s[4] += bf_lo(v.z) - bf_lo(o2.z); s[5] += bf_hi(v.z) - bf_hi(o2.z); s[6] += bf_lo(v.w) - bf_lo(o2.w); s[7] += bf_hi(v.w) - bf_hi(o2.w);
                const float ic = 1.0f / (float)((tl + 1 < w) ? tl + 1 : w);
                u32x4 o;
                o.x = cvt_pk_bf16(s[0] * ic - bf_lo(v.x), s[1] * ic - bf_hi(v.x)); o.y = cvt_pk_bf16(s[2] * ic - bf_lo(v.y), s[3] * ic - bf_hi(v.y));
                o.z = cvt_pk_bf16(s[4] * ic - bf_lo(v.z), s[5] * ic - bf_hi(v.z)); o.w = cvt_pk_bf16(s[6] * ic - bf_lo(v.w), s[7] * ic - bf_hi(v.w));
                *(u32x4*)(pg + (size_t)row * DE + col) = o; }
        }
    }
}

typedef float f32x16 __attribute__((ext_vector_type(16)));
constexpr int SEGC = 64, U_PITCH = 528, S_PITCH = 132, H_PITCH = 272;
constexpr int L_APOW = 0, L_BBAR = L_APOW + 64 * 17 * 8, L_CC = L_BBAR + 64 * 17 * 8, L_KT = L_CC + 16 * 65 * 8, L_UBUF = L_KT + 16 * 16 * 20 * 4,
              L_SBUF = L_UBUF + SEGC * U_PITCH, L_HBUF = L_SBUF + SEGC * S_PITCH * 4, L_SSM_END = L_HBUF + SEGC * H_PITCH;
constexpr int L_FS = L_CC, L_UB = L_FS + 4 * 16 * 64 * 16, L_SB = L_UB + SEGC * U_PITCH;
constexpr int L_EX = L_SB + SEGC * S_PITCH * 4;
constexpr int L_D = L_EX + 8 * 64 * 8;
static_assert(L_D + 64 <= XB_LDS_OFF && S_PITCH * 4 == U_PITCH, "SSM LDS budget");
typedef float __attribute__((may_alias)) f32a; typedef unsigned short __attribute__((may_alias)) u16a;
__device__ __forceinline__ bf16x8 pack8(const float (&v)[8]) {
    u32x4 w; w.x = cvt_pk_bf16(v[0], v[1]); w.y = cvt_pk_bf16(v[2], v[3]); w.z = cvt_pk_bf16(v[4], v[5]); w.w = cvt_pk_bf16(v[6], v[7]);
    return __builtin_bit_cast(bf16x8, w);
}
__device__ void phase_ssm(int j, unsigned char* lds) {
    const ParamsPtr pq = params_ptr();
    unsigned char* ws = pq->ws;
    const int tid = fresh_tid(), lane = tid & 63, wave = __builtin_amdgcn_readfirstlane(tid >> 6), l31 = lane & 31, h = lane >> 5;
    const bf16_t* UG = (const bf16_t*)(ws + WS_GATED); bf16_t* GO = (bf16_t*)(ws + WS_PG);
    f32x2* APOW = (f32x2*)(lds + L_APOW); f32x2* BBAR = (f32x2*)(lds + L_BBAR); f32x2* CC = (f32x2*)(lds + L_CC); float* KT = (float*)(lds + L_KT);
    for (int g = blockIdx.x; g < NG; g += gridDim.x) {
        __syncthreads();
        u32x4 pf[4];
        { const bf16_t* usrc = UG + (size_t)g * GSTR;
#pragma unroll
          for (int it = 0; it < 4; ++it) pf[it] = *(const u32x4*)(usrc + (size_t)(tid + NTHREADS * it) * 8); }
        { f32x4* TMP = (f32x4*)(lds + L_UBUF);
          if (tid < 64) { const int n = tid;
            const float are = pq->in[8][((size_t)j * NG + g) * NS + n], aim = pq->in[9][((size_t)j * NG + g) * NS + n];
            const float dt = expf(pq->in[10][(size_t)j * NG + g]);
            const float mag = expf(are * dt); float sn, cs; sincosf(aim * dt, &sn, &cs);
            const float abr = mag * cs, abi = mag * sn, den = are * are + aim * aim, nr = abr - 1.0f;
            TMP[n] = (f32x4){are * dt, aim * dt, (nr * are + abi * aim) / den, (abi * are - nr * aim) / den}; }
          __syncthreads();
          for (int i = tid; i < 64 * 17; i += NTHREADS) { const int n = i / 17, k = i - n * 17; const f32x4 t4 = TMP[n];
              const float mg = expf(t4[0] * (float)k); float sn, cs; sincosf(t4[1] * (float)k, &sn, &cs); APOW[i] = (f32x2){mg * cs, mg * sn}; }
          for (int i = tid; i < NS * NP; i += NTHREADS) { const int n = i >> 4; const f32x4 t4 = TMP[n]; const size_t o = ((size_t)j * NG + g) * NS * NP + i;
              const float bre = pq->in[11][o], bim = pq->in[12][o]; BBAR[n * 17 + (i & 15)] = (f32x2){t4[2] * bre - t4[3] * bim, t4[2] * bim + t4[3] * bre}; }
          for (int i = tid; i < NP * NS; i += NTHREADS) { const size_t o = ((size_t)j * NG + g) * NP * NS + i; CC[(i >> 6) * 65 + (i & 63)] = (f32x2){pq->in[13][o], pq->in[14][o]}; }
          __syncthreads();
          { const int tau = tid >> 5, q = (tid >> 1) & 15, ph = tid & 1; float ka[8];
#pragma unroll
            for (int i = 0; i < 8; ++i) ka[i] = 0.f;
#pragma unroll 1
            for (int n0 = 0; n0 < NS; n0 += 4) { f32x2 a[4], b[4], c[4][8];
#pragma unroll
                for (int u = 0; u < 4; ++u) { a[u] = APOW[(n0 + u) * 17 + tau]; b[u] = BBAR[(n0 + u) * 17 + q];
#pragma unroll
                    for (int i = 0; i < 8; ++i) c[u][i] = CC[(ph * 8 + i) * 65 + n0 + u]; }
                __builtin_amdgcn_sched_barrier(0);
#pragma unroll
                for (int u = 0; u < 4; ++u) { const float xr = a[u].x * b[u].x - a[u].y * b[u].y, xi = a[u].x * b[u].y + a[u].y * b[u].x;
#pragma unroll
                    for (int i = 0; i < 8; ++i) ka[i] += c[u][i].x * xr - c[u][i].y * xi; } }
#pragma unroll
            for (int i = 0; i < 8; ++i) KT[(tau * 16 + ph * 8 + i) * 20 + q] = ka[i]; }
          __syncthreads(); }
        const int mb1 = wave & 3, cb1 = wave >> 2, mb3 = (wave < 4) ? wave : 11 - wave;
        bf16x8 FT[16], FH[8];
        const int jrow = 2 * mb3 + (l31 >> 4), prow = l31 & 15;
#pragma unroll
        for (int j4 = 0; j4 < 4; ++j4) { f32x4 k0[4], k1[4];
#pragma unroll
            for (int u = 0; u < 4; ++u) { const int jp = 4 * j4 + u; const float* kt = KT + (((jrow - jp) & 15) * 16 + prow) * 20 + 8 * h; k0[u] = *(const f32x4*)kt; k1[u] = *(const f32x4*)(kt + 4); }
            __builtin_amdgcn_sched_barrier(0);
#pragma unroll
            for (int u = 0; u < 4; ++u) { const int jp = 4 * j4 + u; float v[8];
#pragma unroll
                for (int i = 0; i < 4; ++i) { v[i] = (jp <= jrow) ? k0[u][i] : 0.f; v[4 + i] = (jp <= jrow) ? k1[u][i] : 0.f; }
                FT[jp] = pack8(v); } }
#pragma unroll
        for (int ks = 0; ks < 8; ++ks) { f32x2 c[8], a[8];
#pragma unroll
            for (int i = 0; i < 8; ++i) { const int n = (ks * 16 + 8 * h + i) & 63; c[i] = CC[prow * 65 + n]; a[i] = APOW[n * 17 + jrow + 1]; }
            __builtin_amdgcn_sched_barrier(0);
            float v[8];
#pragma unroll
            for (int i = 0; i < 8; ++i) v[i] = (ks >= 4) ? -(c[i].x * a[i].y + c[i].y * a[i].x) : (c[i].x * a[i].x - c[i].y * a[i].y);
            FH[ks] = pack8(v); }
        const f32x2 A16 = APOW[lane * 17 + 16];
        f32x2 A128 = A16;
#pragma unroll
        for (int i = 0; i < 3; ++i) A128 = (f32x2){A128.x * A128.x - A128.y * A128.y, 2.0f * A128.x * A128.y};
        __syncthreads();
#pragma unroll 1
        for (int k = 0; k < 8; ++k) { const int e = tid + NTHREADS * k, el = e & 63, jp = (e >> 6) & 15, mb = e >> 10, m = 32 * mb + (el & 31), n = m & 63, eh = el >> 5; const bool im = m >= 64;
            const f32x2 a = APOW[n * 17 + 15 - jp]; f32x2 b[8]; float v[8];
#pragma unroll
            for (int i = 0; i < 8; ++i) b[i] = BBAR[n * 17 + 8 * eh + i];
            __builtin_amdgcn_sched_barrier(0);
#pragma unroll
            for (int i = 0; i < 8; ++i) v[i] = im ? (a.x * b[i].y + a.y * b[i].x) : (a.x * b[i].x - a.y * b[i].y);
            *(bf16x8*)(lds + L_FS + e * 16) = pack8(v); }
        const float* dsk = pq->in[15] + (size_t)j * DE + g * NP;
        if (tid < 16) ((float*)(lds + L_D))[tid] = dsk[tid];
        const bf16_t* ug = UG + (size_t)g * GSTR; bf16_t* gbase = GO + (size_t)g * GSTR;
        float hr = 0.f, hi = 0.f;
        for (int seg = 0; seg < 8; ++seg) {
            LDS_BARRIER();
#pragma unroll
            for (int it = 0; it < 4; ++it) { const int pid = tid + NTHREADS * it, tt = pid >> 1, half = pid & 1;
                *(u32x4*)(lds + L_UB + (tt >> 4) * U_PITCH + (tt & 15) * 32 + half * 16) = pf[it]; }
            if (seg < 7) {
#pragma unroll
                for (int it = 0; it < 4; ++it) pf[it] = *(const u32x4*)(ug + (size_t)(seg + 1) * (SEGC * TCH * 16) + (size_t)(tid + NTHREADS * it) * 8); }
            LDS_BARRIER();
            { f32x16 acc;
#pragma unroll
              for (int i = 0; i < 16; ++i) acc[i] = 0.f;
              const unsigned char* ub = lds + L_UB + (cb1 * 32 + l31) * U_PITCH + h * 16; const unsigned char* fs = lds + L_FS + (mb1 * 16 * 64 + lane) * 16;
#pragma unroll
              for (int g4 = 0; g4 < 2; ++g4) { bf16x8 A[8], B[8];
#pragma unroll
                  for (int i = 0; i < 8; ++i) { A[i] = *(const bf16x8*)(fs + (g4 * 8 + i) * 1024); B[i] = *(const bf16x8*)(ub + (g4 * 8 + i) * 32); }
#pragma unroll
                  for (int i = 0; i < 8; ++i) acc = __builtin_amdgcn_mfma_f32_32x32x16_bf16(A[i], B[i], acc, 0, 0, 0);
                  }
              float* sp = (float*)(lds + L_SB) + (cb1 * 32 + l31) * S_PITCH + 32 * mb1 + 4 * h;
#pragma unroll
              for (int rr = 0; rr < 4; ++rr) *(f32x4*)(sp + 8 * rr) = (f32x4){acc[4 * rr], acc[4 * rr + 1], acc[4 * rr + 2], acc[4 * rr + 3]}; }
            LDS_BARRIER();
            { const f32a* sb = (const f32a*)(lds + L_SB) + (8 * wave) * S_PITCH + lane; float sr[8], si[8];
#pragma unroll
              for (int k = 0; k < 8; ++k) { sr[k] = sb[k * S_PITCH]; si[k] = sb[k * S_PITCH + 64]; }
              float lr = 0.f, li = 0.f;
#pragma unroll
              for (int k = 0; k < 8; ++k) { const float nr = A16.x * lr - A16.y * li + sr[k], ni = A16.x * li + A16.y * lr + si[k]; lr = nr; li = ni; }
              *(f32x2*)(lds + L_EX + (wave * 64 + lane) * 8) = (f32x2){lr, li}; }
            LDS_BARRIER();
            { if ((seg & 3) == 0) { hr = 0.f; hi = 0.f; }
              float xr = hr, xi = hi, mr = hr, mi = hi;
              f32x2 ev[8];
#pragma unroll
              for (int v = 0; v < 8; ++v) ev[v] = *(const f32x2*)(lds + L_EX + (v * 64 + lane) * 8);
#pragma unroll
              for (int v = 0; v < 8; ++v) { mr = (v == wave) ? xr : mr; mi = (v == wave) ? xi : mi;
                  const float nr = A128.x * xr - A128.y * xi + ev[v].x, ni = A128.x * xi + A128.y * xr + ev[v].y; xr = nr; xi = ni; }
              hr = xr; hi = xi;
              const f32a* sb = (const f32a*)(lds + L_SB) + (8 * wave) * S_PITCH + lane; float sr[8], si[8];
#pragma unroll
              for (int k = 0; k < 8; ++k) { sr[k] = sb[k * S_PITCH]; si[k] = sb[k * S_PITCH + 64]; }
              u16a* hb = (u16a*)(lds + L_SB) + (8 * wave) * (2 * S_PITCH) + lane; float yr = mr, yi = mi;
#pragma unroll
              for (int k = 0; k < 8; ++k) { const unsigned pk = cvt_pk_bf16(yr, yi); hb[k * (2 * S_PITCH)] = (unsigned short)(pk & 0xffffu); hb[k * (2 * S_PITCH) + 64] = (unsigned short)(pk >> 16);
                  const float nr = A16.x * yr - A16.y * yi + sr[k], ni = A16.x * yi + A16.y * yr + si[k]; yr = nr; yi = ni; } }
            LDS_BARRIER();
#pragma unroll 1
            for (int cb = 0; cb < 2; ++cb) {
                f32x16 acc;
#pragma unroll
                for (int i = 0; i < 16; ++i) acc[i] = 0.f;
                const int ch = cb * 32 + l31;
                const unsigned char* ub0 = lds + L_UB + ch * U_PITCH + h * 16; const unsigned char* hb0 = lds + L_SB + ch * (S_PITCH * 4) + h * 16;
#pragma unroll
                for (int g8 = 0; g8 < 2; ++g8) if (8 * g8 <= 2 * mb3 + 1) { bf16x8 B[8];
#pragma unroll
                    for (int i = 0; i < 8; ++i) B[i] = *(const bf16x8*)(ub0 + (g8 * 8 + i) * 32);
#pragma unroll
                    for (int i = 0; i < 8; ++i) acc = __builtin_amdgcn_mfma_f32_32x32x16_bf16(FT[g8 * 8 + i], B[i], acc, 0, 0, 0); }
                { bf16x8 B[8];
#pragma unroll
                    for (int i = 0; i < 8; ++i) B[i] = *(const bf16x8*)(hb0 + i * 32);
#pragma unroll
                    for (int i = 0; i < 8; ++i) acc = __builtin_amdgcn_mfma_f32_32x32x16_bf16(FH[i], B[i], acc, 0, 0, 0); }
                u32x2 uwv[4]; const f32x4 dA = *(const f32x4*)(lds + L_D + 16 * h), dB = *(const f32x4*)(lds + L_D + 32 + 16 * h);
#pragma unroll
                for (int rr = 0; rr < 4; ++rr) uwv[rr] = *(const u32x2*)(lds + L_UB + ch * U_PITCH + (2 * mb3 + (rr >> 1)) * 32 + (8 * (rr & 1) + 4 * h) * 2);
#pragma unroll
                for (int rr = 0; rr < 4; ++rr) { const int jj = 2 * mb3 + (rr >> 1), p0 = 8 * (rr & 1) + 4 * h;
                    const u32x2 uw = uwv[rr]; const f32x4 d4 = (rr & 1) ? dB : dA;
                    const float y0 = acc[4 * rr] + d4[0] * bf_lo(uw.x), y1 = acc[4 * rr + 1] + d4[1] * bf_hi(uw.x);
                    const float y2 = acc[4 * rr + 2] + d4[2] * bf_lo(uw.y), y3 = acc[4 * rr + 3] + d4[3] * bf_hi(uw.y);
                    u32x2 o; o.x = cvt_pk_bf16(gelu_tanh_f(y0), gelu_tanh_f(y1)); o.y = cvt_pk_bf16(gelu_tanh_f(y2), gelu_tanh_f(y3));
                    *(u32x2*)(gbase + ((size_t)seg * (SEGC * TCH) + ch * TCH + jj) * 16 + p0) = o; }
            }
        }
        __syncthreads();
    }
}

__device__ void phase_final() {
    const ParamsPtr pq = params_ptr(); struct { const float* in[3]; float* out; unsigned char* ws; } p{{pq->in[0], pq->in[1], pq->in[2]}, pq->out, pq->ws};
    const float* rowss = (const float*)(p.ws + WS_ROWSS) + 4 * M_TOK; const float* gf = p.in[2];
    const int tid = fresh_tid(), lane = tid & 63, wave = tid >> 6;
    for (int row = blockIdx.x * 8 + wave; row < M_TOK; row += gridDim.x * 8) {
        const float inv = rsqrtf(rowss[row] * (1.0f / DM) + EPS); float4* xr = (float4*)(p.out + (size_t)row * DM);
        float4 xv[8], gv[8];
#pragma unroll
        for (int i = 0; i < 8; ++i) { xv[i] = xr[i * 64 + lane]; gv[i] = ((const float4*)gf)[i * 64 + lane]; }
#pragma unroll
        for (int i = 0; i < 8; ++i) { float4 v = xv[i]; const float4 g = gv[i];
            v.x *= inv * g.x; v.y *= inv * g.y; v.z *= inv * g.z; v.w *= inv * g.w; xr[i * 64 + lane] = v; }
    }
}

#define XB_TMO      128
#define XB_XCNT(j)  (256  + 64 * (j))
#define XB_XSUB(j)  (1280 + 64 * (j))
#define XB_XGEN(j)  (2304 + 64 * (j))
#define XB_TOP      3328
#define XB_TOPGEN   3392
#define XCD_BAR_WORDS 3456
#define XB_SPIN_CAP (1u << 18)
__device__ __forceinline__ unsigned xb_ld(unsigned* p)              { return __hip_atomic_load(p, __ATOMIC_RELAXED, __HIP_MEMORY_SCOPE_AGENT); }
__device__ __forceinline__ unsigned xb_add(unsigned* p, unsigned v) { return __hip_atomic_fetch_add(p, v, __ATOMIC_RELAXED, __HIP_MEMORY_SCOPE_AGENT); }
__device__ __forceinline__ unsigned xb_xcc_id() { return (unsigned)__builtin_amdgcn_s_getreg((3 << 11) | 20) & 0xFu; }
#define XB_SPIN(cond, bar) do { unsigned _sp = 0; while (cond) { __builtin_amdgcn_s_sleep(1); \
    if ((++_sp & 255u) == 0u) { if (xb_ld(&(bar)[XB_TMO])) break; if (_sp > XB_SPIN_CAP) { atomicAdd(&(bar)[XB_TMO], 1u); break; } } } } while (0)
struct XcdBarrier { unsigned* bar; unsigned x; volatile LAS unsigned* st; };
__device__ __forceinline__ XcdBarrier xcd_barrier_post(unsigned* bar, volatile LAS unsigned* st) {
    XcdBarrier b; b.bar = bar; b.x = xb_xcc_id(); b.st = st;
    if (threadIdx.x == 0) (void)xb_add(&bar[XB_XCNT(b.x)], 1u);
    return b;
}
__device__ __forceinline__ void xcd_barrier_complete(unsigned* bar, unsigned x, unsigned& nloc, unsigned& nx) {
    const unsigned G = gridDim.x * gridDim.y * gridDim.z;
    unsigned sum, cnt, mine, sp = 0u;
    for (;;) {
        sum = 0u; cnt = 0u; mine = 0u;
#pragma unroll
        for (unsigned j = 0; j < 16; ++j) { const unsigned c = xb_ld(&bar[XB_XCNT(j)]); sum += c; cnt += (c > 0u) ? 1u : 0u; mine = (j == x) ? c : mine; }
        if (sum == G) break;
        __builtin_amdgcn_s_sleep(1);
        if ((++sp & 255u) == 0u) { if (xb_ld(&bar[XB_TMO])) break; if (sp > XB_SPIN_CAP) { atomicAdd(&bar[XB_TMO], 1u); break; } }
    }
    nloc = mine > 0u ? mine : 1u; nx = cnt > 0u ? cnt : 1u;
}
__device__ __forceinline__ void xcd_barrier(const XcdBarrier& b) {
    asm volatile("s_waitcnt vmcnt(0)" ::: "memory");
    __syncthreads();
    if (threadIdx.x == 0) {
        unsigned* bar = b.bar;
        __builtin_amdgcn_s_waitcnt(0);
        unsigned nloc = b.st[0], nx = b.st[1];
        if (nloc == 0u) { xcd_barrier_complete(bar, b.x, nloc, nx); b.st[0] = nloc; b.st[1] = nx; }
        const unsigned old = xb_add(&bar[XB_XSUB(b.x)], 1u);
        const unsigned gen = old / nloc;
        if (old + 1u == (gen + 1u) * nloc) {
            __builtin_amdgcn_fence(__ATOMIC_RELEASE, "agent");
            asm volatile("s_waitcnt vmcnt(0)" ::: "memory");
            const unsigned og = xb_add(&bar[XB_TOP], 1u);
            const unsigned tg = og / nx;
            if (og + 1u == (tg + 1u) * nx) xb_add(&bar[XB_TOPGEN], 1u);
            else XB_SPIN(xb_ld(&bar[XB_TOPGEN]) == tg, bar);
            __builtin_amdgcn_fence(__ATOMIC_ACQUIRE, "agent");
            xb_add(&bar[XB_XGEN(b.x)], 1u);
            asm volatile("s_waitcnt vmcnt(0)" ::: "memory");
        } else {
            XB_SPIN(xb_ld(&bar[XB_XGEN(b.x)]) == gen, bar);
            __builtin_amdgcn_fence(__ATOMIC_ACQUIRE, "agent");
            asm volatile("s_waitcnt vmcnt(0)" ::: "memory");
        }
    }
    __syncthreads();
}

constexpr int N_PHASES_K = 18;
__global__ void __launch_bounds__(NTHREADS, 2) fwd_megakernel(Params p_unused) {
    extern __shared__ __attribute__((aligned(16))) unsigned char lds[];
    LAS unsigned char* ldsl = (LAS unsigned char*)lds;
    float* ldsf = (float*)lds;
    cg::grid_group grid = cg::this_grid();
    const int lo = params_ptr()->ph_lo, hi = params_ptr()->ph_hi;
    const int G = gridDim.x, bx = blockIdx.x;
    int ph = 0;
    volatile LAS unsigned* xbst = (volatile LAS unsigned*)(ldsl + XB_LDS_OFF);
    if (threadIdx.x < 4) xbst[threadIdx.x] = 0u;
    __syncthreads();
    XcdBarrier xbar; xbar.bar = (unsigned*)(params_ptr()->ws + WS_BAR); xbar.x = 0; xbar.st = xbst;
    if (hi - lo > 1) xbar = xcd_barrier_post((unsigned*)(params_ptr()->ws + WS_BAR), xbst);
    const bool fusefin = (G == 256) && (hi - lo == N_PHASES_K);
#define SEAM() do { if (lo <= ph && ph + 1 < hi && !(fusefin && ph == N_PHASES_K - 2)) { if (hi > N_PHASES_K) grid.sync(); else xcd_barrier(xbar); } ++ph; } while (0)
#define RUN (lo <= ph && ph < hi)
#define WSP(off) ((bf16_t*)(q->ws + (off)))
    if (RUN) phase_prep(ldsf);
    SEAM();
#pragma unroll 1
    for (int l = 0; l < 4; ++l) {
        const int j = l >> 1; const bool ssm = (l & 1);
        const size_t wofs = ssm ? WS_WSSM + j * W_SSM_SZ : WS_W + j * W_POOL_SZ;
        if (RUN) { const ParamsPtr q = params_ptr(); pg8::Gemm g{WSP(WS_HBF), WSP(wofs), M_TOK, DE2, DM, 2u * DM, 32u, 128u, 0}; pg8::StaticOrder S; S.init(M_TOK, DE2, G, bx);
            pg8::EpiIn E{WSP(WS_UZ), (const float*)(q->ws + WS_ROWSS) + l * M_TOK, ssm ? WSP(WS_GATED) : nullptr}; pg8::gemm_phase<pg8::EpiIn>(ldsl, g, S, E); }
        SEAM();
        if (!ssm) {
            if (RUN) phase_pool();
            SEAM();
            if (RUN) { const ParamsPtr q = params_ptr(); pg8::Gemm g{WSP(WS_PG), WSP(wofs + W_POOL_GRP), M_TOK, DE, 1024, 2u * DE, 32u, 128u, 1}; pg8::StaticOrder S; S.init(M_TOK, DE, G, bx);
                pg8::EpiPool E{WSP(WS_GATED), WSP(WS_UZ) + DE, q->in[5] + (size_t)j * DE}; pg8::gemm_phase<pg8::EpiPool>(ldsl, g, S, E); }
            SEAM();
        } else {
            if (RUN) phase_ssm(j, lds);
            SEAM();
            if (RUN) { const ParamsPtr q = params_ptr(); pg8::Gemm g{WSP(WS_PG), WSP(wofs + W_SSM_GLU), M_TOK, DE, DE, 32u, 2u * GSTR, 8u * GSTR, 0}; pg8::StaticOrder S; S.init(M_TOK, DE, G, bx);
                pg8::EpiGlu E{WSP(WS_GATED), WSP(WS_UZ) + DE, WSP(WS_PG), q->in[17] + (size_t)j * DE}; pg8::gemm_phase<pg8::EpiGlu>(ldsl, g, S, E); }
            SEAM();
        }
        if (RUN && fusefin && l == 3) { const ParamsPtr q = params_ptr(); pg8::Gemm g{WSP(WS_GATED), WSP(wofs + W_SSM_OUT), M_TOK, DM, DE, 2u * DE, 32u, 128u, 0}; pg8::StaticOrder S; S.init(M_TOK, DM, G, bx);
            pg8::EpiOutFinal E{(const float*)q->out, q->out, q->in[2], (float*)(q->ws + WS_ROWSS) + 4 * M_TOK, (unsigned*)(q->ws + WS_PCNT)}; pg8::gemm_phase<pg8::EpiOutFinal>(ldsl, g, S, E); }
        else if (RUN) { const ParamsPtr q = params_ptr(); pg8::Gemm g{WSP(WS_GATED), WSP(wofs + (ssm ? W_SSM_OUT : W_POOL_OUT)), M_TOK, DM, DE, 2u * DE, 32u, 128u, 0}; pg8::StaticOrder S; S.init(M_TOK, DM, G, bx);
            pg8::EpiOut E{(l == 0) ? q->in[0] : (const float*)q->out, q->out, (l < 3) ? WSP(WS_HBF) : nullptr, q->in[1] + (size_t)(l < 3 ? l + 1 : 0) * DM, (float*)(q->ws + WS_ROWSS) + (l + 1) * M_TOK}; pg8::gemm_phase<pg8::EpiOut>(ldsl, g, S, E); }
        SEAM();
    }
    if (RUN && !fusefin) phase_final();
#undef SEAM
#undef RUN
#undef WSP
}
constexpr int N_PHASES = 18;

extern "C" void kernel_launch(void* const* d_in, const int* in_sizes, int n_in, void* d_out, int out_size, void* d_ws, size_t ws_size, hipStream_t stream) {
    static int grid = 0;
    if (grid == 0) {
        if (n_in != 19 || out_size != M_TOK * DM || ws_size < WS_END) { fprintf(stderr, "kernel_launch: unexpected shapes (n_in %d out %d ws %zu need %zu)\n", n_in, out_size, ws_size, (size_t)WS_END); grid = -1; return; }
        int dev = 0, cus = 0, per_cu = 0;
        hipGetDevice(&dev); hipDeviceGetAttribute(&cus, hipDeviceAttributeMultiprocessorCount, dev);
        if (hipFuncSetAttribute((const void*)fwd_megakernel, hipFuncAttributeMaxDynamicSharedMemorySize, LDS_BYTES) != hipSuccess) { fprintf(stderr, "kernel_launch: hipFuncSetAttribute failed\n"); grid = -1; return; }
        hipOccupancyMaxActiveBlocksPerMultiprocessor(&per_cu, (const void*)fwd_megakernel, NTHREADS, LDS_BYTES);
        if (per_cu < 1) { fprintf(stderr, "kernel_launch: occupancy query says %d blocks per CU\n", per_cu); per_cu = 1; }
        (void)hipGetLastError();
        grid = cus;
    }
    if (grid < 0) return;
    Params p{};
    for (int i = 0; i < 19; ++i) p.in[i] = (const float*)d_in[i];
    p.out = (float*)d_out; p.ws = (unsigned char*)d_ws;
#if ONE_LAUNCH
    p.ph_lo = 0; p.ph_hi = N_PHASES;
    if (hipMemsetAsync((char*)d_ws + WS_BAR, 0, 16 * 1024 + 32 * 256, stream) != hipSuccess) { fprintf(stderr, "kernel_launch: memset of barrier words failed\n"); return; }
    void* args[] = {&p};
    hipError_t e = hipLaunchCooperativeKernel((const void*)fwd_megakernel, dim3(grid), dim3(NTHREADS), args, LDS_BYTES, stream);
    if (e != hipSuccess) fprintf(stderr, "cooperative launch failed: %s (grid %d)\n", hipGetErrorString(e), grid);
#else
    for (int ph = 0; ph < N_PHASES; ++ph) { p.ph_lo = ph; p.ph_hi = ph + 1;
        hipLaunchKernelGGL(fwd_megakernel, dim3(grid), dim3(NTHREADS), LDS_BYTES, stream, p); }
#endif
}
```

```cpp
#include <hip/hip_runtime.h>
#include <hip/hip_cooperative_groups.h>
#include <cstdio>
namespace cg = cooperative_groups;

#ifndef ONE_LAUNCH
#define ONE_LAUNCH 1
#endif

#define LAS __attribute__((address_space(3)))
typedef unsigned short bf16_t;
typedef short bf16x8 __attribute__((ext_vector_type(8)));
typedef float f32x4 __attribute__((ext_vector_type(4)));
typedef float f32x2 __attribute__((ext_vector_type(2)));
typedef unsigned u32x4 __attribute__((ext_vector_type(4)));
typedef unsigned u32x2 __attribute__((ext_vector_type(2)));

constexpr int M_TOK = 8192, SEQ = 4096, DM = 2048, DE = 4096, DE2 = 8192;
constexpr int NG = 256, NS = 64, NP = 16, TCH = 16, NCH = SEQ / TCH;
constexpr float EPS = 1e-6f;
constexpr int NTHREADS = 512;
constexpr int GSTR = M_TOK * 16 + 2176;
constexpr int HSTR = 2 * (SEQ / 16) * 128 + 1088;
constexpr int LDS_BYTES = 163840;
constexpr int XB_LDS_OFF = LDS_BYTES - 64;

constexpr size_t MiB = 1024 * 1024;
constexpr size_t WS_HBF = 0;
constexpr size_t WS_UZ = WS_HBF + 34 * MiB;
constexpr size_t WS_PG = WS_UZ + 128 * MiB;
constexpr size_t WS_GATED = WS_PG + 66 * MiB;
constexpr size_t WS_W = WS_GATED + 66 * MiB;
constexpr size_t W_POOL_IN = 0, W_POOL_GRP = 32 * MiB, W_POOL_OUT = 40 * MiB, W_POOL_SZ = 56 * MiB;
constexpr size_t W_SSM_IN = 0, W_SSM_GLU = 32 * MiB, W_SSM_OUT = 64 * MiB, W_SSM_SZ = 80 * MiB;
constexpr size_t WS_WSSM = WS_W + 2 * W_POOL_SZ;
constexpr size_t WS_ROWSS = WS_WSSM + 2 * W_SSM_SZ;
constexpr size_t WS_BAR = WS_ROWSS + 512 * 1024;
constexpr size_t WS_PCNT = WS_BAR + 16 * 1024;
constexpr size_t WS_END = WS_ROWSS + 1 * MiB;

struct Params {
    const float* in[19];
    float* out;
    unsigned char* ws;
    int ph_lo, ph_hi;
};

typedef const __attribute__((address_space(4))) Params* ParamsPtr;
__device__ __forceinline__ ParamsPtr params_ptr() { ParamsPtr q = (ParamsPtr)__builtin_amdgcn_kernarg_segment_ptr(); asm volatile("" : "+s"(q)); return q; }
__device__ __forceinline__ int fresh_tid() { int t = threadIdx.x; asm volatile("" : "+v"(t)); return t; }

__device__ __forceinline__ unsigned cvt_pk_bf16(float lo, float hi) { unsigned r; asm volatile("v_cvt_pk_bf16_f32 %0, %1, %2" : "=v"(r) : "v"(lo), "v"(hi)); return r; }
__device__ __forceinline__ float bf_lo(unsigned w) { return __uint_as_float(w << 16); }
__device__ __forceinline__ float bf_hi(unsigned w) { return __uint_as_float(w & 0xffff0000u); }
__device__ __forceinline__ float bf2f(bf16_t b) { return __uint_as_float(((unsigned)b) << 16); }
__device__ __forceinline__ float fast_rcp(float x) { return __builtin_amdgcn_rcpf(x); }
__device__ __forceinline__ float silu_f(float z) { return z * fast_rcp(1.0f + __builtin_amdgcn_exp2f(z * -1.44269504f)); }
__device__ __forceinline__ float sigmoid_f(float z) { return fast_rcp(1.0f + __expf(-z)); }
__device__ __forceinline__ float gelu_tanh_f(float y) {
    const float t = __builtin_amdgcn_exp2f(y * __builtin_fmaf(-0.10294324f, y * y, -2.3022082f));
    return y * fast_rcp(1.0f + t);
}
__device__ __forceinline__ float glu_gate_f(float g, float v, float z) {
    const float ev = __builtin_amdgcn_exp2f(v * -1.44269504f), ez = __builtin_amdgcn_exp2f(z * -1.44269504f);
    return g * z * fast_rcp((1.0f + ev) * (1.0f + ez));
}

namespace pg8 {
constexpr int BM = 256, BK = 64, HALF = 128, HTB = HALF * BK * 2, STAGE_BYTES = 8 * HTB, NXCD = 8, WGM = 8;
__host__ __device__ __forceinline__ int lds_byte(int r, int c) { const int st = (r >> 4) * 2 + (c >> 5), rr = r & 15, cc = c & 31, ob = rr * 64 + cc * 2; return st * 1024 + (ob ^ (((ob >> 9) & 1) << 5)); }
__host__ __device__ __forceinline__ void stage_rc(int b, int& R, int& C) { const int st = b / 1024, sb = b % 1024, swz = sb ^ (((sb >> 9) & 1) << 5); R = (st >> 1) * 16 + swz / 64; C = (st & 1) * 32 + (swz % 64) / 2; }
__host__ __device__ __forceinline__ int perm32(int rho) { const int n = rho >> 4, i = rho & 15; return 8 * (i >> 2) + 4 * n + (i & 3); }

struct Unit { int pm, pn; };
struct Gemm { const bf16_t* A; const bf16_t* Bt; int M, N, K; unsigned a_row, a_c16, a_kt; int grouped; };

struct StaticOrder {
    int nM, nN, nwg, G, c;
    __device__ void init(int M, int N, int G_, int c_) { nM = M / BM; nN = N / BM; nwg = nM * nN; G = G_; c = c_; }
    __device__ bool next(int i, Unit& u) const {
        const long L = (long)i * G + c; if (L >= nwg) return false;
        int wgid = (int)L; { const int q = nwg / NXCD, r = nwg % NXCD, xcd = wgid % NXCD, off = wgid / NXCD; wgid = (xcd < r ? xcd * (q + 1) : r * (q + 1) + (xcd - r) * q) + off; }
        const int nig = WGM * nN, gid = wgid / nig, fm = gid * WGM, gsz = (nM - fm) < WGM ? (nM - fm) : WGM;
        u.pm = fm + ((wgid % nig) % gsz); u.pn = (wgid % nig) / gsz; return true;
    }
};

template <class Epi>
__device__ __forceinline__ void gemm_phase(LAS unsigned char* lds, const Gemm g, const StaticOrder& S, const Epi& E) {
    const int tid = fresh_tid(), wid = __builtin_amdgcn_readfirstlane(tid >> 6), lane = tid & 63, wr = wid >> 2, wc = wid & 3, fr = lane & 15, fq = lane >> 4;
    const int K = g.K, nt = K / BK;
    unsigned voffA[2], voffB[2];
#pragma unroll
    for (int i = 0; i < 2; ++i) { int R, C; stage_rc(tid * 16 + i * 8192, R, C); const int Rb = Epi::PERM ? ((R & ~31) + perm32(R & 31)) : R;
        voffA[i] = (unsigned)R * g.a_row + (unsigned)(C >> 4) * g.a_c16 + (unsigned)(C & 15) * 2u; voffB[i] = (unsigned)(Rb * K + C) * 2u; }
    const size_t kstep = (size_t)(BK * 2), kstepA = (size_t)g.a_kt;
    const size_t hstepA = (size_t)HALF * g.a_row, hstepB = (size_t)HALF * K * 2;
    const size_t tstepA = 2 * hstepA, tstepB = 2 * hstepB;
    const size_t gstepA = g.grouped ? (size_t)K * 2 : 0;
    const unsigned ldsw = (unsigned)wid * 1024u;
    const int aoff = lds_byte(wr * 64 + fr, fq * 8), boff = lds_byte(wc * 32 + fr, fq * 8);
#define PG8_SA(b, h) (((b) * 2 + (h)) * HTB)
#define PG8_SB(b, h) ((4 + (b) * 2 + (h)) * HTB)
#define PG8_STAGE(bufoff, gbase, voff) do { _Pragma("unroll") for (int _i = 0; _i < 2; ++_i) \
        __builtin_amdgcn_global_load_lds((const unsigned*)((const char*)(gbase) + (voff)[_i]), (LAS unsigned*)(lds + (bufoff) + ldsw + _i * 8192), 16, 0, 0); } while (0)
#define PG8_LDA(dst, b, h) do { _Pragma("unroll") for (int m = 0; m < 4; ++m) _Pragma("unroll") for (int k = 0; k < 2; ++k) dst[m][k] = *(const LAS bf16x8*)(lds + PG8_SA(b, h) + aoff + m * 2048 + k * 1024); } while (0)
#define PG8_LDB(dst, b, h) do { _Pragma("unroll") for (int n = 0; n < 2; ++n) _Pragma("unroll") for (int k = 0; k < 2; ++k) dst[n][k] = *(const LAS bf16x8*)(lds + PG8_SB(b, h) + boff + n * 2048 + k * 1024); } while (0)
#define PG8_MMA(ai, bj, At, Bt) do { __builtin_amdgcn_s_setprio(1); _Pragma("unroll") for (int m = 0; m < 4; ++m) _Pragma("unroll") for (int n = 0; n < 2; ++n) _Pragma("unroll") for (int k = 0; k < 2; ++k) \
        acc[ai][bj][m][n] = __builtin_amdgcn_mfma_f32_16x16x32_bf16(Bt[n][k], At[m][k], acc[ai][bj][m][n], 0, 0, 0); __builtin_amdgcn_s_setprio(0); } while (0)
#define PG8_WAIT_V(n) asm volatile("s_waitcnt vmcnt(" #n ")" ::: "memory")
#define PG8_WAIT_L(n) asm volatile("s_waitcnt lgkmcnt(" #n ")" ::: "memory")
#define PG8_BAR __builtin_amdgcn_s_barrier()
#define PG8_SCHED __builtin_amdgcn_sched_barrier(0)
    Unit cur, nxt; int ui = 0;
    if (!S.next(0, cur)) return;
    typename Epi::Pre pre = E.pre(cur, wr, fr);
    f32x4 acc[2][2][4][2];
#pragma unroll
    for (int a = 0; a < 2; ++a)
#pragma unroll
        for (int b = 0; b < 2; ++b)
#pragma unroll
            for (int m = 0; m < 4; ++m)
#pragma unroll
                for (int n = 0; n < 2; ++n) acc[a][b][m][n] = (f32x4){0.f, 0.f, 0.f, 0.f};
    bf16x8 At[4][2], B0[2][2], B1[2][2];
    const char* cA = (const char*)g.A + (size_t)cur.pm * tstepA + (size_t)(cur.pn >> 2) * gstepA; const char* cB = (const char*)g.Bt + (size_t)cur.pn * tstepB;
    PG8_STAGE(PG8_SB(0, 0), cB, voffB); PG8_STAGE(PG8_SA(0, 0), cA, voffA); PG8_STAGE(PG8_SB(0, 1), cB + hstepB, voffB); PG8_STAGE(PG8_SA(0, 1), cA + hstepA, voffA);
    if (wr == 1) PG8_BAR;
    PG8_WAIT_V(4); PG8_BAR;
    PG8_STAGE(PG8_SB(1, 0), cB + kstep, voffB); PG8_STAGE(PG8_SA(1, 0), cA + kstepA, voffA); PG8_STAGE(PG8_SB(1, 1), cB + hstepB + kstep, voffB);
    PG8_WAIT_V(6); PG8_BAR;
    for (;;) {
        const bool has_next = S.next(ui + 1, nxt);
        const char* nA = has_next ? (const char*)g.A + (size_t)nxt.pm * tstepA + (size_t)(nxt.pn >> 2) * gstepA : cA; const char* nB = has_next ? (const char*)g.Bt + (size_t)nxt.pn * tstepB : cB;
        for (int t = 0; t < nt; t += 2) {
            const bool last = (t == nt - 2);
            const char* a1 = cA + (size_t)(t + 1) * kstepA;
            const char* a2 = last ? nA : cA + (size_t)(t + 2) * kstepA; const char* b2 = last ? nB : cB + (size_t)(t + 2) * kstep;
            const char* a3 = a2 + kstepA; const char* b3 = b2 + kstep;
            PG8_LDB(B0, 0, 0); PG8_SCHED; PG8_LDA(At, 0, 0); PG8_STAGE(PG8_SA(1, 1), a1 + hstepA, voffA);
            PG8_WAIT_L(8); PG8_BAR; PG8_WAIT_L(0); PG8_MMA(0, 0, At, B0); PG8_BAR; PG8_SCHED;
            PG8_LDB(B1, 0, 1); PG8_STAGE(PG8_SB(0, 0), b2, voffB);
            PG8_BAR; PG8_WAIT_L(0); PG8_MMA(0, 1, At, B1); PG8_BAR;
            PG8_LDA(At, 0, 1); PG8_STAGE(PG8_SA(0, 0), a2, voffA);
            PG8_BAR; PG8_WAIT_L(0); PG8_MMA(1, 0, At, B0); PG8_BAR; PG8_SCHED;
            PG8_STAGE(PG8_SB(0, 1), b2 + hstepB, voffB);
            PG8_WAIT_V(6); PG8_BAR; PG8_MMA(1, 1, At, B1); PG8_BAR;
            PG8_LDB(B0, 1, 0); PG8_SCHED; PG8_LDA(At, 1, 0); PG8_STAGE(PG8_SA(0, 1), a2 + hstepA, voffA);
            PG8_WAIT_L(8); PG8_BAR; PG8_WAIT_L(0); PG8_MMA(0, 0, At, B0); PG8_BAR; PG8_SCHED;
            PG8_LDB(B1, 1, 1); PG8_STAGE(PG8_SB(1, 0), b3, voffB);
            PG8_BAR; PG8_WAIT_L(0); PG8_MMA(0, 1, At, B1); PG8_BAR;
            PG8_LDA(At, 1, 1); PG8_STAGE(PG8_SA(1, 0), a3, voffA);
            PG8_BAR; PG8_WAIT_L(0); PG8_MMA(1, 0, At, B0); PG8_BAR; PG8_SCHED;
            PG8_STAGE(PG8_SB(1, 1), b3 + hstepB, voffB);
            PG8_WAIT_V(6); PG8_BAR; PG8_MMA(1, 1, At, B1); PG8_BAR;
        }
        if constexpr (!Epi::AFTER_DRAIN) E(acc, cur, wr, wc, fr, fq, pre);
        if (!has_next) break;
#pragma unroll
        for (int a = 0; a < 2; ++a)
#pragma unroll
            for (int b = 0; b < 2; ++b)
#pragma unroll
                for (int m = 0; m < 4; ++m)
#pragma unroll
                    for (int n = 0; n < 2; ++n) acc[a][b][m][n] = (f32x4){0.f, 0.f, 0.f, 0.f};
        cur = nxt; cA = nA; cB = nB; ++ui;
        pre = E.pre(cur, wr, fr);
    }
    PG8_WAIT_V(0);
    if (wr == 0) PG8_BAR;
    PG8_BAR;
    if constexpr (Epi::AFTER_DRAIN) E.fused(acc, cur, wr, wc, fr, fq);
#undef PG8_SA
#undef PG8_SB
#undef PG8_STAGE
#undef PG8_LDA
#undef PG8_LDB
#undef PG8_MMA
#undef PG8_WAIT_V
#undef PG8_WAIT_L
#undef PG8_BAR
#undef PG8_SCHED
}

struct EpiIn {
    static constexpr bool AFTER_DRAIN = false;
    static constexpr bool PERM = true;
    bf16_t* O; const float* rowss; bf16_t* UG;
    struct Pre { float rs[8]; };
    __device__ __forceinline__ Pre pre(const Unit& u, int wr, int fr) const { Pre p; const int row0 = u.pm * BM + wr * 64 + fr;
#pragma unroll
        for (int g8 = 0; g8 < 8; ++g8) p.rs[g8] = rowss[row0 + (g8 >> 2) * HALF + (g8 & 3) * 16];
        return p; }
    __device__ __forceinline__ void operator()(const f32x4 (&acc)[2][2][4][2], const Unit& u, int wr, int wc, int fr, int fq, const Pre& pp) const {
        const int row0 = u.pm * BM + wr * 64 + fr, col0 = u.pn * BM + wc * 32 + 8 * fq;
        const bool gm = (UG != nullptr) && (u.pn < DE / BM);
        const float (&rs)[8] = pp.rs;
#pragma unroll
        for (int ai = 0; ai < 2; ++ai)
#pragma unroll
            for (int m = 0; m < 4; ++m) { const int r = row0 + ai * HALF + m * 16; const float inv = rsqrtf(rs[ai * 4 + m] * (1.0f / DM) + EPS);
#pragma unroll
                for (int bj = 0; bj < 2; ++bj) { const f32x4 v0 = acc[ai][bj][m][0] * inv, v1 = acc[ai][bj][m][1] * inv; const int c = col0 + bj * HALF;
                    u32x4 w; w.x = cvt_pk_bf16(v0[0], v0[1]); w.y = cvt_pk_bf16(v0[2], v0[3]); w.z = cvt_pk_bf16(v1[0], v1[1]); w.w = cvt_pk_bf16(v1[2], v1[3]);
                    bf16_t* dst = gm ? UG + (size_t)(c >> 4) * GSTR + r * 16 + (c & 15) : O + (size_t)r * DE2 + c;
                    *(u32x4*)dst = w; } }
    }
};
struct EpiPool {
    static constexpr bool AFTER_DRAIN = false;
    static constexpr bool PERM = true;
    bf16_t* O; const bf16_t* Z; const float* scale;
    struct Pre {};
    __device__ __forceinline__ Pre pre(const Unit&, int, int) const { return Pre{}; }
    __device__ __forceinline__ void operator()(const f32x4 (&acc)[2][2][4][2], const Unit& u, int wr, int wc, int fr, int fq, const Pre&) const {
        const int row0 = u.pm * BM + wr * 64 + fr, col0 = u.pn * BM + wc * 32 + 8 * fq;
        f32x4 sc[2][2];
#pragma unroll
        for (int bj = 0; bj < 2; ++bj) { sc[bj][0] = *(const f32x4*)(scale + col0 + bj * HALF); sc[bj][1] = *(const f32x4*)(scale + col0 + bj * HALF + 4); }
#pragma unroll
        for (int bj = 0; bj < 2; ++bj) { const int c = col0 + bj * HALF;
            u32x4 zv[8];
#pragma unroll
            for (int g8 = 0; g8 < 8; ++g8) zv[g8] = *(const u32x4*)(Z + (size_t)(row0 + (g8 >> 2) * HALF + (g8 & 3) * 16) * DE2 + c);
#pragma unroll
            for (int ai = 0; ai < 2; ++ai)
#pragma unroll
                for (int m = 0; m < 4; ++m) { const int r = row0 + ai * HALF + m * 16;
                    const u32x4 zw = zv[ai * 4 + m];
                    const f32x4 a0 = acc[ai][bj][m][0] * sc[bj][0], a1 = acc[ai][bj][m][1] * sc[bj][1];
                    u32x4 w;
                    w.x = cvt_pk_bf16(a0[0] * silu_f(bf_lo(zw.x)), a0[1] * silu_f(bf_hi(zw.x)));
                    w.y = cvt_pk_bf16(a0[2] * silu_f(bf_lo(zw.y)), a0[3] * silu_f(bf_hi(zw.y)));
                    w.z = cvt_pk_bf16(a1[0] * silu_f(bf_lo(zw.z)), a1[1] * silu_f(bf_hi(zw.z)));
                    w.w = cvt_pk_bf16(a1[2] * silu_f(bf_lo(zw.w)), a1[3] * silu_f(bf_hi(zw.w)));
                    *(u32x4*)(O + (size_t)r * DE + c) = w; } }
    }
};
struct EpiGlu {
    static constexpr bool AFTER_DRAIN = false;
    static constexpr bool PERM = true;
    bf16_t* O; const bf16_t* Z; const bf16_t* Gm; const float* bias;
    struct Pre {};
    __device__ __forceinline__ Pre pre(const Unit&, int, int) const { return Pre{}; }
    __device__ __forceinline__ void operator()(const f32x4 (&acc)[2][2][4][2], const Unit& u, int wr, int wc, int fr, int fq, const Pre&) const {
        const int row0 = u.pm * BM + wr * 64 + fr, col0 = u.pn * BM + wc * 32 + 8 * fq;
        f32x4 bs[2][2];
#pragma unroll
        for (int bj = 0; bj < 2; ++bj) { bs[bj][0] = *(const f32x4*)(bias + col0 + bj * HALF); bs[bj][1] = *(const f32x4*)(bias + col0 + bj * HALF + 4); }
#pragma unroll
        for (int bj = 0; bj < 2; ++bj) { const int c = col0 + bj * HALF;
#pragma unroll
            for (int ai = 0; ai < 2; ++ai) { u32x4 zv[4], gv[4];
#pragma unroll
                for (int m = 0; m < 4; ++m) { const int r = row0 + ai * HALF + m * 16; zv[m] = *(const u32x4*)(Z + (size_t)r * DE2 + c); gv[m] = *(const u32x4*)(Gm + (size_t)(c >> 4) * GSTR + r * 16 + (c & 15)); }
#pragma unroll
                for (int m = 0; m < 4; ++m) { const int r = row0 + ai * HALF + m * 16;
                    const u32x4 zw = zv[m], gw = gv[m];
                    const f32x4 a0 = acc[ai][bj][m][0] + bs[bj][0], a1 = acc[ai][bj][m][1] + bs[bj][1];
                    u32x4 w;
                    w.x = cvt_pk_bf16(glu_gate_f(bf_lo(gw.x), a0[0], bf_lo(zw.x)), glu_gate_f(bf_hi(gw.x), a0[1], bf_hi(zw.x)));
                    w.y = cvt_pk_bf16(glu_gate_f(bf_lo(gw.y), a0[2], bf_lo(zw.y)), glu_gate_f(bf_hi(gw.y), a0[3], bf_hi(zw.y)));
                    w.z = cvt_pk_bf16(glu_gate_f(bf_lo(gw.z), a1[0], bf_lo(zw.z)), glu_gate_f(bf_hi(gw.z), a1[1], bf_hi(zw.z)));
                    w.w = cvt_pk_bf16(glu_gate_f(bf_lo(gw.w), a1[2], bf_lo(zw.w)), glu_gate_f(bf_hi(gw.w), a1[3], bf_hi(zw.w)));
                    *(u32x4*)(O + (size_t)r * DE + c) = w; } } }
    }
};
struct EpiOut {
    static constexpr bool AFTER_DRAIN = false;
    static constexpr bool PERM = false;
    const float* Xin; float* X; bf16_t* H; const float* gnext; float* rowss_next;
    struct Pre {};
    __device__ __forceinline__ Pre pre(const Unit&, int, int) const { return Pre{}; }
    __device__ __forceinline__ void operator()(const f32x4 (&acc)[2][2][4][2], const Unit& u, int wr, int wc, int fr, int fq, const Pre&) const {
        const int row0 = u.pm * BM + wr * 64 + fr, col0 = u.pn * BM + wc * 32 + 4 * fq;
        f32x4 gv[2][2];
#pragma unroll
        for (int bj = 0; bj < 2; ++bj)
#pragma unroll
            for (int n = 0; n < 2; ++n) gv[bj][n] = *(const f32x4*)(gnext + col0 + bj * HALF + n * 16);
        f32x4 xb[2][2][2];
#pragma unroll
        for (int bj = 0; bj < 2; ++bj)
#pragma unroll
            for (int n = 0; n < 2; ++n) xb[0][bj][n] = *(const f32x4*)(Xin + (size_t)row0 * DM + col0 + bj * HALF + n * 16);
#pragma unroll
        for (int grp = 0; grp < 8; ++grp) { const int ai = grp >> 2, m = grp & 3, cur = grp & 1; const int r = row0 + ai * HALF + m * 16; float ss = 0.f;
            if (grp < 7) { const int rn = row0 + ((grp + 1) >> 2) * HALF + ((grp + 1) & 3) * 16;
#pragma unroll
                for (int bj = 0; bj < 2; ++bj)
#pragma unroll
                    for (int n = 0; n < 2; ++n) xb[cur ^ 1][bj][n] = *(const f32x4*)(Xin + (size_t)rn * DM + col0 + bj * HALF + n * 16); }
#pragma unroll
            for (int bj = 0; bj < 2; ++bj)
#pragma unroll
                for (int n = 0; n < 2; ++n) { const int c = col0 + bj * HALF + n * 16;
                    const f32x4 xv = xb[cur][bj][n] + acc[ai][bj][m][n]; *(f32x4*)(X + (size_t)r * DM + c) = xv;
                    ss += (xv[0] * xv[0] + xv[1] * xv[1]) + (xv[2] * xv[2] + xv[3] * xv[3]);
                    if (H) { const f32x4 hv = xv * gv[bj][n]; u32x2 w; w.x = cvt_pk_bf16(hv[0], hv[1]); w.y = cvt_pk_bf16(hv[2], hv[3]);
                        *(u32x2*)(H + (size_t)r * DM + c) = w; } }
            ss += __shfl_xor(ss, 16); ss += __shfl_xor(ss, 32);
            if (fq == 0) atomicAdd(rowss_next + r, ss); }
    }
};
struct EpiOutFinal {
    static constexpr bool AFTER_DRAIN = true;
    static constexpr bool PERM = false;
    const float* Xin; float* Out; const float* gfin; float* rowss; unsigned* cnt;
    struct Pre {};
    __device__ __forceinline__ Pre pre(const Unit&, int, int) const { return Pre{}; }
    __device__ __forceinline__ void fused(f32x4 (&acc)[2][2][4][2], const Unit& u, int wr, int wc, int fr, int fq) const {
        const int row0 = u.pm * BM + wr * 64 + fr, col0 = u.pn * BM + wc * 32 + 4 * fq;
        f32x4 xb[2][2][2];
#pragma unroll
        for (int bj = 0; bj < 2; ++bj)
#pragma unroll
            for (int n = 0; n < 2; ++n) xb[0][bj][n] = *(const f32x4*)(Xin + (size_t)row0 * DM + col0 + bj * HALF + n * 16);
#pragma unroll
        for (int grp = 0; grp < 8; ++grp) { const int ai = grp >> 2, m = grp & 3, cur = grp & 1; const int r = row0 + ai * HALF + m * 16; float ss = 0.f;
            if (grp < 7) { const int rn = row0 + ((grp + 1) >> 2) * HALF + ((grp + 1) & 3) * 16;
#pragma unroll
                for (int bj = 0; bj < 2; ++bj)
#pragma unroll
                    for (int n = 0; n < 2; ++n) xb[cur ^ 1][bj][n] = *(const f32x4*)(Xin + (size_t)rn * DM + col0 + bj * HALF + n * 16); }
#pragma unroll
            for (int bj = 0; bj < 2; ++bj)
#pragma unroll
                for (int n = 0; n < 2; ++n) { const f32x4 xv = xb[cur][bj][n] + acc[ai][bj][m][n]; acc[ai][bj][m][n] = xv;
                    ss += (xv[0] * xv[0] + xv[1] * xv[1]) + (xv[2] * xv[2] + xv[3] * xv[3]); }
            ss += __shfl_xor(ss, 16); ss += __shfl_xor(ss, 32);
            if (fq == 0) atomicAdd(rowss + r, ss); }
        asm volatile("s_waitcnt vmcnt(0)" ::: "memory");
        __syncthreads();
        if (threadIdx.x == 0) { unsigned* c = cnt + 64 * u.pm;
            __hip_atomic_fetch_add(c, 1u, __ATOMIC_RELAXED, __HIP_MEMORY_SCOPE_AGENT);
            unsigned sp = 0;
            while (__hip_atomic_load(c, __ATOMIC_RELAXED, __HIP_MEMORY_SCOPE_AGENT) < 8u) { __builtin_amdgcn_s_sleep(2); if (++sp > (1u << 22)) break; } }
        __syncthreads();
        f32x4 gv[2][2]; float rs[8];
#pragma unroll
        for (int bj = 0; bj < 2; ++bj)
#pragma unroll
            for (int n = 0; n < 2; ++n) gv[bj][n] = *(const f32x4*)(gfin + col0 + bj * HALF + n * 16);
#pragma unroll
        for (int g8 = 0; g8 < 8; ++g8) rs[g8] = __hip_atomic_load(rowss + row0 + (g8 >> 2) * HALF + (g8 & 3) * 16, __ATOMIC_RELAXED, __HIP_MEMORY_SCOPE_AGENT);
#pragma unroll
        for (int ai = 0; ai < 2; ++ai)
#pragma unroll
            for (int m = 0; m < 4; ++m) { const int r = row0 + ai * HALF + m * 16; const float inv = rsqrtf(rs[ai * 4 + m] * (1.0f / DM) + EPS);
#pragma unroll
                for (int bj = 0; bj < 2; ++bj)
#pragma unroll
                    for (int n = 0; n < 2; ++n) *(f32x4*)(Out + (size_t)r * DM + col0 + bj * HALF + n * 16) = acc[ai][bj][m][n] * inv * gv[bj][n]; }
    }
};
}

#define LDS_BARRIER() asm volatile("s_waitcnt lgkmcnt(0)\n\ts_barrier" ::: "memory")
struct CvtJob { const float* src; bf16_t* dst; int K, N, k0, n0; };
constexpr int N_CVT_TILES_K = 2 * 4352;
__device__ __forceinline__ CvtJob cvt_decode(int t, const ParamsPtr pq) {
    t = N_CVT_TILES_K - 1 - t;
    CvtJob J; const int jj = t / 4352; int r = t % 4352; unsigned char* ws = pq->ws;
    if (r < 1792) { bf16_t* wp = (bf16_t*)(ws + WS_W + jj * W_POOL_SZ);
        if (r < 1024) { J.src = pq->in[3] + (size_t)jj * DM * DE2; J.dst = wp + W_POOL_IN / 2; J.K = DM; J.N = DE2; }
        else if (r < 1280) { r -= 1024; const int g = r >> 6; r &= 63; J.src = pq->in[4] + ((size_t)jj * 4 + g) * 1024 * 1024; J.dst = wp + W_POOL_GRP / 2 + (size_t)g * 1024 * 1024; J.K = 1024; J.N = 1024; }
        else { r -= 1280; J.src = pq->in[6] + (size_t)jj * DE * DM; J.dst = wp + W_POOL_OUT / 2; J.K = DE; J.N = DM; }
    } else { r -= 1792; bf16_t* wp = (bf16_t*)(ws + WS_WSSM + jj * W_SSM_SZ);
        if (r < 1024) { J.src = pq->in[7] + (size_t)jj * DM * DE2; J.dst = wp + W_SSM_IN / 2; J.K = DM; J.N = DE2; }
        else if (r < 2048) { r -= 1024; J.src = pq->in[16] + (size_t)jj * DE * DE; J.dst = wp + W_SSM_GLU / 2; J.K = DE; J.N = DE; }
        else { r -= 2048; J.src = pq->in[18] + (size_t)jj * DE * DM; J.dst = wp + W_SSM_OUT / 2; J.K = DE; J.N = DM; }
    }
    const int tn = J.N / 256; J.k0 = (r / tn) * 64; J.n0 = (r % tn) * 256; return J;
}
constexpr int N_CVT_TILES = 2 * 4352;
__device__ void convert_weights(float* tile) {
    const ParamsPtr pq = params_ptr();
    const int tid = fresh_tid(), rl = tid >> 6, c4 = (tid & 63) * 4;
    float4 cur[8];
    int t = blockIdx.x;
    if (t < N_CVT_TILES) { const CvtJob J = cvt_decode(t, pq);
#pragma unroll
        for (int ii = 0; ii < 8; ++ii) { const f32x4 t_ = __builtin_nontemporal_load((const f32x4*)(J.src + (size_t)(J.k0 + ii * 8 + rl) * J.N + J.n0 + c4)); cur[ii] = make_float4(t_[0], t_[1], t_[2], t_[3]); } }
    for (; t < N_CVT_TILES; t += gridDim.x) {
        const CvtJob J = cvt_decode(t, pq);
#pragma unroll
        for (int ii = 0; ii < 8; ++ii) { float* tp = tile + (ii * 8 + rl) * 257 + c4; tp[0] = cur[ii].x; tp[1] = cur[ii].y; tp[2] = cur[ii].z; tp[3] = cur[ii].w; }
        const int tn = t + gridDim.x;
        if (tn < N_CVT_TILES) { const CvtJob Jn = cvt_decode(tn, pq);
#pragma unroll
            for (int ii = 0; ii < 8; ++ii) { const f32x4 t_ = __builtin_nontemporal_load((const f32x4*)(Jn.src + (size_t)(Jn.k0 + ii * 8 + rl) * Jn.N + Jn.n0 + c4)); cur[ii] = make_float4(t_[0], t_[1], t_[2], t_[3]); } }
        LDS_BARRIER();
#pragma unroll
        for (int ii = 0; ii < 4; ++ii) { const int f = tid + 512 * ii, n = f >> 3, k8 = (f & 7) * 8; const float* tp = tile + k8 * 257 + n;
            u32x4 w; w.x = cvt_pk_bf16(tp[0], tp[257]); w.y = cvt_pk_bf16(tp[2 * 257], tp[3 * 257]); w.z = cvt_pk_bf16(tp[4 * 257], tp[5 * 257]); w.w = cvt_pk_bf16(tp[6 * 257], tp[7 * 257]);
            *(u32x4*)(J.dst + (size_t)(J.n0 + n) * J.K + J.k0 + k8) = w; }
        LDS_BARRIER();
    }
}

__device__ void phase_prep(float* ldsf) {
    const ParamsPtr pq = params_ptr(); Params p;
#pragma unroll
    for (int i = 0; i < 19; ++i) p.in[i] = pq->in[i];
    p.out = pq->out; p.ws = pq->ws; p.ph_lo = 0; p.ph_hi = 0;
    const int tid = fresh_tid(), lane = tid & 63, wave = tid >> 6;
    const float* x = p.in[0]; const float* g0 = p.in[1];
    bf16_t* hbf = (bf16_t*)(p.ws + WS_HBF); float* rowss = (float*)(p.ws + WS_ROWSS);
    for (int i = blockIdx.x * NTHREADS + tid; i < 4 * M_TOK; i += gridDim.x * NTHREADS) rowss[M_TOK + i] = 0.f;
    convert_weights(ldsf);
    float4 gq[8];
#pragma unroll
    for (int i = 0; i < 8; ++i) gq[i] = ((const float4*)g0)[i * 64 + lane];
    for (int row = blockIdx.x * 8 + wave; row < M_TOK; row += gridDim.x * 8) {
        const float4* xr = (const float4*)(x + (size_t)row * DM);
        float4 xv[8];
#pragma unroll
        for (int i = 0; i < 8; ++i) xv[i] = xr[i * 64 + lane];
        float ss = 0.f;
#pragma unroll
        for (int i = 0; i < 8; ++i) { const int idx = i * 64 + lane; const float4 v = xv[i];
            ss += (v.x * v.x + v.y * v.y) + (v.z * v.z + v.w * v.w);
            u32x2 w; w.x = cvt_pk_bf16(v.x * gq[i].x, v.y * gq[i].y); w.y = cvt_pk_bf16(v.z * gq[i].z, v.w * gq[i].w);
            *(u32x2*)(hbf + (size_t)row * DM + idx * 4) = w; }
#pragma unroll
        for (int o = 32; o >= 1; o >>= 1) ss += __shfl_xor(ss, o);
        if (lane == 0) rowss[row] = ss;
    }
}

__device__ void phase_pool() {
    const ParamsPtr p_ = params_ptr(); unsigned char* ws = p_->ws;
    const bf16_t* uz = (const bf16_t*)(ws + WS_UZ); bf16_t* pg = (bf16_t*)(ws + WS_PG);
    constexpr int RB = 32;
    for (int idx = blockIdx.x * NTHREADS + fresh_tid(); idx < (M_TOK / RB) * (DE / 8); idx += gridDim.x * NTHREADS) {
        const int c8 = idx % (DE / 8), rb = idx / (DE / 8), col = c8 * 8, g = col >> 10, w = 2 << g, row0 = rb * RB, tl0 = row0 & (SEQ - 1);
        float s[8];
#pragma unroll
        for (int i = 0; i < 8; ++i) s[i] = 0.f;
        const int nh = (tl0 < w) ? tl0 : w;
        { u32x4 hv[16];
#pragma unroll
          for (int k = 1; k <= 16; ++k) hv[k - 1] = (k <= nh) ? *(const u32x4*)(uz + (size_t)(row0 - k) * DE2 + col) : (u32x4){0u, 0u, 0u, 0u};
#pragma unroll
          for (int k = 0; k < 16; ++k) { const u32x4 v = hv[k];
            s[0] += bf_lo(v.x); s[1] += bf_hi(v.x); s[2] += bf_lo(v.y); s[3] += bf_hi(v.y); s[4] += bf_lo(v.z); s[5] += bf_hi(v.z); s[6] += bf_lo(v.w); s[7] += bf_hi(v.w); } }
#pragma unroll 1
        for (int r0 = 0; r0 < RB; r0 += 8) {
            u32x4 vv[8], ov[8];
#pragma unroll
            for (int k = 0; k < 8; ++k) { const int row = row0 + r0 + k, tl = tl0 + r0 + k;
                vv[k] = *(const u32x4*)(uz + (size_t)row * DE2 + col);
                ov[k] = (tl >= w) ? *(const u32x4*)(uz + (size_t)(row - w) * DE2 + col) : (u32x4){0u, 0u, 0u, 0u}; }
#pragma unroll
            for (int k = 0; k < 8; ++k) { const int row = row0 + r0 + k, tl = tl0 + r0 + k; const u32x4 v = vv[k], o2 = ov[k];
                s[0] += bf_lo(v.x) - bf_lo(o2.x); s[1] += bf_hi(v.x) - bf_hi(o2.x); s[2] += bf_lo(v.y) - bf_lo(o2.y); s[3] += bf_hi(v.y) - bf_hi(o2.y);
                s[4] += bf_lo(v.z) - bf_lo(o2.z); s[5] += bf_hi(v.z) - bf_hi(o2.z); s[6] += bf_lo(v.w) - bf_lo(o2.w); s[7] += bf_hi(v.w) - bf_hi(o2.w);
                const float ic = 1.0f / (float)((tl + 1 < w) ? tl + 1 : w);
                u32x4 o;
                o.x = cvt_pk_bf16(s[0] * ic - bf_lo(v.x), s[1] * ic - bf_hi(v.x)); o.y = cvt_pk_bf16(s[2] * ic - bf_lo(v.y), s[3] * ic - bf_hi(v.y));
                o.z = cvt_pk_bf16(s[4] * ic - bf_lo(v.z), s[5] * ic - bf_hi(v.z)); o.w = cvt_pk_bf16(s[6] * ic - bf_lo(v.w), s[7] * ic - bf_hi(v.w));
                *(u32x4*)(pg + (size_t)row * DE + col) = o; }
        }
    }
}

typedef float f32x16 __attribute__((ext_vector_type(16)));
constexpr int SEGC = 64, U_PITCH = 528, S_PITCH = 132, H_PITCH = 272;
constexpr int L_APOW = 0, L_BBAR = L_APOW + 64 * 17 * 8, L_CC = L_BBAR + 64 * 17 * 8, L_KT = L_CC + 16 * 65 * 8, L_UBUF = L_KT + 16 * 16 * 20 * 4,
              L_SBUF = L_UBUF + SEGC * U_PITCH, L_HBUF = L_SBUF + SEGC * S_PITCH * 4, L_SSM_END = L_HBUF + SEGC * H_PITCH;
constexpr int L_FS = L_CC, L_UB = L_FS + 4 * 16 * 64 * 16, L_SB = L_UB + SEGC * U_PITCH;
constexpr int L_EX = L_SB + SEGC * S_PITCH * 4;
constexpr int L_D = L_EX + 8 * 64 * 8;
static_assert(L_D + 64 <= XB_LDS_OFF && S_PITCH * 4 == U_PITCH, "SSM LDS budget");
typedef float __attribute__((may_alias)) f32a; typedef unsigned short __attribute__((may_alias)) u16a;
__device__ __forceinline__ bf16x8 pack8(const float (&v)[8]) {
    u32x4 w; w.x = cvt_pk_bf16(v[0], v[1]); w.y = cvt_pk_bf16(v[2], v[3]); w.z = cvt_pk_bf16(v[4], v[5]); w.w = cvt_pk_bf16(v[6], v[7]);
    return __builtin_bit_cast(bf16x8, w);
}
__device__ __forceinline__ void ssm_tables(int j, int g, unsigned char* lds) {
    const ParamsPtr pq = params_ptr();
    const int tid = fresh_tid();
    f32x2* APOW = (f32x2*)(lds + L_APOW); f32x2* BBAR = (f32x2*)(lds + L_BBAR); f32x2* CC = (f32x2*)(lds + L_CC); float* KT = (float*)(lds + L_KT);
    __syncthreads();
        { f32x4* TMP = (f32x4*)(lds + L_UBUF);
          if (tid < 64) { const int n = tid;
            const float are = pq->in[8][((size_t)j * NG + g) * NS + n], aim = pq->in[9][((size_t)j * NG + g) * NS + n];
            const float dt = expf(pq->in[10][(size_t)j * NG + g]);
            const float mag = expf(are * dt); float sn, cs; sincosf(aim * dt, &sn, &cs);
            const float abr = mag * cs, abi = mag * sn, den = are * are + aim * aim, nr = abr - 1.0f;
            TMP[n] = (f32x4){are * dt, aim * dt, (nr * are + abi * aim) / den, (abi * are - nr * aim) / den}; }
          __syncthreads();
          for (int i = tid; i < 64 * 17; i += NTHREADS) { const int n = i / 17, k = i - n * 17; const f32x4 t4 = TMP[n];
              const float mg = expf(t4[0] * (float)k); float sn, cs; sincosf(t4[1] * (float)k, &sn, &cs); APOW[i] = (f32x2){mg * cs, mg * sn}; }
          for (int i = tid; i < NS * NP; i += NTHREADS) { const int n = i >> 4; const f32x4 t4 = TMP[n]; const size_t o = ((size_t)j * NG + g) * NS * NP + i;
              const float bre = pq->in[11][o], bim = pq->in[12][o]; BBAR[n * 17 + (i & 15)] = (f32x2){t4[2] * bre - t4[3] * bim, t4[2] * bim + t4[3] * bre}; }
          for (int i = tid; i < NP * NS; i += NTHREADS) { const size_t o = ((size_t)j * NG + g) * NP * NS + i; CC[(i >> 6) * 65 + (i & 63)] = (f32x2){pq->in[13][o], pq->in[14][o]}; }
          __syncthreads();
          { const int tau = tid >> 5, q = (tid >> 1) & 15, ph = tid & 1; float ka[8];
#pragma unroll
            for (int i = 0; i < 8; ++i) ka[i] = 0.f;
#pragma unroll 1
            for (int n0 = 0; n0 < NS; n0 += 4) { f32x2 a[4], b[4], c[4][8];
#pragma unroll
                for (int u = 0; u < 4; ++u) { a[u] = APOW[(n0 + u) * 17 + tau]; b[u] = BBAR[(n0 + u) * 17 + q];
#pragma unroll
                    for (int i = 0; i < 8; ++i) c[u][i] = CC[(ph * 8 + i) * 65 + n0 + u]; }
                __builtin_amdgcn_sched_barrier(0);
#pragma unroll
                for (int u = 0; u < 4; ++u) { const float xr = a[u].x * b[u].x - a[u].y * b[u].y, xi = a[u].x * b[u].y + a[u].y * b[u].x;
#pragma unroll
                    for (int i = 0; i < 8; ++i) ka[i] += c[u][i].x * xr - c[u][i].y * xi; } }
#pragma unroll
            for (int i = 0; i < 8; ++i) KT[(tau * 16 + ph * 8 + i) * 20 + q] = ka[i]; }
          __syncthreads(); }
}

__device__ void phase_ssm(int j, unsigned char* lds, bool pretab) {
    const ParamsPtr pq = params_ptr();
    unsigned char* ws = pq->ws;
    const int tid = fresh_tid(), lane = tid & 63, wave = __builtin_amdgcn_readfirstlane(tid >> 6), l31 = lane & 31, h = lane >> 5;
    const bf16_t* UG = (const bf16_t*)(ws + WS_GATED); bf16_t* GO = (bf16_t*)(ws + WS_PG);
    f32x2* APOW = (f32x2*)(lds + L_APOW); f32x2* BBAR = (f32x2*)(lds + L_BBAR); f32x2* CC = (f32x2*)(lds + L_CC); float* KT = (float*)(lds + L_KT);
    for (int g = blockIdx.x; g < NG; g += gridDim.x) {
        __syncthreads();
        u32x4 pf[4];
        { const bf16_t* usrc = UG + (size_t)g * GSTR;
#pragma unroll
          for (int it = 0; it < 4; ++it) pf[it] = *(const u32x4*)(usrc + (size_t)(tid + NTHREADS * it) * 8); }
        if (!pretab) ssm_tables(j, g, lds);
        const int mb1 = wave & 3, cb1 = wave >> 2, mb3 = (wave < 4) ? wave : 11 - wave;
        bf16x8 FT[16], FH[8];
        const int jrow = 2 * mb3 + (l31 >> 4), prow = l31 & 15;
#pragma unroll
        for (int j4 = 0; j4 < 4; ++j4) { f32x4 k0[4], k1[4];
#pragma unroll
            for (int u = 0; u < 4; ++u) { const int jp = 4 * j4 + u; const float* kt = KT + (((jrow - jp) & 15) * 16 + prow) * 20 + 8 * h; k0[u] = *(const f32x4*)kt; k1[u] = *(const f32x4*)(kt + 4); }
            __builtin_amdgcn_sched_barrier(0);
#pragma unroll
            for (int u = 0; u < 4; ++u) { const int jp = 4 * j4 + u; float v[8];
#pragma unroll
                for (int i = 0; i < 4; ++i) { v[i] = (jp <= jrow) ? k0[u][i] : 0.f; v[4 + i] = (jp <= jrow) ? k1[u][i] : 0.f; }
                FT[jp] = pack8(v); } }
#pragma unroll
        for (int ks = 0; ks < 8; ++ks) { f32x2 c[8], a[8];
#pragma unroll
            for (int i = 0; i < 8; ++i) { const int n = (ks * 16 + 8 * h + i) & 63; c[i] = CC[prow * 65 + n]; a[i] = APOW[n * 17 + jrow + 1]; }
            __builtin_amdgcn_sched_barrier(0);
            float v[8];
#pragma unroll
            for (int i = 0; i < 8; ++i) v[i] = (ks >= 4) ? -(c[i].x * a[i].y + c[i].y * a[i].x) : (c[i].x * a[i].x - c[i].y * a[i].y);
            FH[ks] = pack8(v); }
        const f32x2 A16 = APOW[lane * 17 + 16];
        f32x2 A128 = A16;
#pragma unroll
        for (int i = 0; i < 3; ++i) A128 = (f32x2){A128.x * A128.x - A128.y * A128.y, 2.0f * A128.x * A128.y};
        __syncthreads();
#pragma unroll 1
        for (int k = 0; k < 8; ++k) { const int e = tid + NTHREADS * k, el = e & 63, jp = (e >> 6) & 15, mb = e >> 10, m = 32 * mb + (el & 31), n = m & 63, eh = el >> 5; const bool im = m >= 64;
            const f32x2 a = APOW[n * 17 + 15 - jp]; f32x2 b[8]; float v[8];
#pragma unroll
            for (int i = 0; i < 8; ++i) b[i] = BBAR[n * 17 + 8 * eh + i];
            __builtin_amdgcn_sched_barrier(0);
#pragma unroll
            for (int i = 0; i < 8; ++i) v[i] = im ? (a.x * b[i].y + a.y * b[i].x) : (a.x * b[i].x - a.y * b[i].y);
            *(bf16x8*)(lds + L_FS + e * 16) = pack8(v); }
        const float* dsk = pq->in[15] + (size_t)j * DE + g * NP;
        if (tid < 16) ((float*)(lds + L_D))[tid] = dsk[tid];
        const bf16_t* ug = UG + (size_t)g * GSTR; bf16_t* gbase = GO + (size_t)g * GSTR;
        float hr = 0.f, hi = 0.f;
        for (int seg = 0; seg < 8; ++seg) {
            LDS_BARRIER();
#pragma unroll
            for (int it = 0; it < 4; ++it) { const int pid = tid + NTHREADS * it, tt = pid >> 1, half = pid & 1;
                *(u32x4*)(lds + L_UB + (tt >> 4) * U_PITCH + (tt & 15) * 32 + half * 16) = pf[it]; }
            if (seg < 7) {
#pragma unroll
                for (int it = 0; it < 4; ++it) pf[it] = *(const u32x4*)(ug + (size_t)(seg + 1) * (SEGC * TCH * 16) + (size_t)(tid + NTHREADS * it) * 8); }
            LDS_BARRIER();
            { f32x16 acc;
#pragma unroll
              for (int i = 0; i < 16; ++i) acc[i] = 0.f;
              const unsigned char* ub = lds + L_UB + (cb1 * 32 + l31) * U_PITCH + h * 16; const unsigned char* fs = lds + L_FS + (mb1 * 16 * 64 + lane) * 16;
#pragma unroll
              for (int g4 = 0; g4 < 2; ++g4) { bf16x8 A[8], B[8];
#pragma unroll
                  for (int i = 0; i < 8; ++i) { A[i] = *(const bf16x8*)(fs + (g4 * 8 + i) * 1024); B[i] = *(const bf16x8*)(ub + (g4 * 8 + i) * 32); }
#pragma unroll
                  for (int i = 0; i < 8; ++i) acc = __builtin_amdgcn_mfma_f32_32x32x16_bf16(A[i], B[i], acc, 0, 0, 0);
                  }
              float* sp = (float*)(lds + L_SB) + (cb1 * 32 + l31) * S_PITCH + 32 * mb1 + 4 * h;
#pragma unroll
              for (int rr = 0; rr < 4; ++rr) *(f32x4*)(sp + 8 * rr) = (f32x4){acc[4 * rr], acc[4 * rr + 1], acc[4 * rr + 2], acc[4 * rr + 3]}; }
            LDS_BARRIER();
            { const f32a* sb = (const f32a*)(lds + L_SB) + (8 * wave) * S_PITCH + lane; float sr[8], si[8];
#pragma unroll
              for (int k = 0; k < 8; ++k) { sr[k] = sb[k * S_PITCH]; si[k] = sb[k * S_PITCH + 64]; }
              float lr = 0.f, li = 0.f;
#pragma unroll
              for (int k = 0; k < 8; ++k) { const float nr = A16.x * lr - A16.y * li + sr[k], ni = A16.x * li + A16.y * lr + si[k]; lr = nr; li = ni; }
              *(f32x2*)(lds + L_EX + (wave * 64 + lane) * 8) = (f32x2){lr, li}; }
            LDS_BARRIER();
            { if ((seg & 3) == 0) { hr = 0.f; hi = 0.f; }
              float xr = hr, xi = hi, mr = hr, mi = hi;
              f32x2 ev[8];
#pragma unroll
              for (int v = 0; v < 8; ++v) ev[v] = *(const f32x2*)(lds + L_EX + (v * 64 + lane) * 8);
#pragma unroll
              for (int v = 0; v < 8; ++v) { mr = (v == wave) ? xr : mr; mi = (v == wave) ? xi : mi;
                  const float nr = A128.x * xr - A128.y * xi + ev[v].x, ni = A128.x * xi + A128.y * xr + ev[v].y; xr = nr; xi = ni; }
              hr = xr; hi = xi;
              const f32a* sb = (const f32a*)(lds + L_SB) + (8 * wave) * S_PITCH + lane; float sr[8], si[8];
#pragma unroll
              for (int k = 0; k < 8; ++k) { sr[k] = sb[k * S_PITCH]; si[k] = sb[k * S_PITCH + 64]; }
              u16a* hb = (u16a*)(lds + L_SB) + (8 * wave) * (2 * S_PITCH) + lane; float yr = mr, yi = mi;
#pragma unroll
              for (int k = 0; k < 8; ++k) { const unsigned pk = cvt_pk_bf16(yr, yi); hb[k * (2 * S_PITCH)] = (unsigned short)(pk & 0xffffu); hb[k * (2 * S_PITCH) + 64] = (unsigned short)(pk >> 16);
                  const float nr = A16.x * yr - A16.y * yi + sr[k], ni = A16.x * yi + A16.y * yr + si[k]; yr = nr; yi = ni; } }
            LDS_BARRIER();
#pragma unroll 1
            for (int cb = 0; cb < 2; ++cb) {
                f32x16 acc;
#pragma unroll
                for (int i = 0; i < 16; ++i) acc[i] = 0.f;
                const int ch = cb * 32 + l31;
                const unsigned char* ub0 = lds + L_UB + ch * U_PITCH + h * 16; const unsigned char* hb0 = lds + L_SB + ch * (S_PITCH * 4) + h * 16;
#pragma unroll
                for (int g8 = 0; g8 < 2; ++g8) if (8 * g8 <= 2 * mb3 + 1) { bf16x8 B[8];
#pragma unroll
                    for (int i = 0; i < 8; ++i) B[i] = *(const bf16x8*)(ub0 + (g8 * 8 + i) * 32);
#pragma unroll
                    for (int i = 0; i < 8; ++i) acc = __builtin_amdgcn_mfma_f32_32x32x16_bf16(FT[g8 * 8 + i], B[i], acc, 0, 0, 0); }
                { bf16x8 B[8];
#pragma unroll
                    for (int i = 0; i < 8; ++i) B[i] = *(const bf16x8*)(hb0 + i * 32);
#pragma unroll
                    for (int i = 0; i < 8; ++i) acc = __builtin_amdgcn_mfma_f32_32x32x16_bf16(FH[i], B[i], acc, 0, 0, 0); }
                u32x2 uwv[4]; const f32x4 dA = *(const f32x4*)(lds + L_D + 16 * h), dB = *(const f32x4*)(lds + L_D + 32 + 16 * h);
#pragma unroll
                for (int rr = 0; rr < 4; ++rr) uwv[rr] = *(const u32x2*)(lds + L_UB + ch * U_PITCH + (2 * mb3 + (rr >> 1)) * 32 + (8 * (rr & 1) + 4 * h) * 2);
#pragma unroll
                for (int rr = 0; rr < 4; ++rr) { const int jj = 2 * mb3 + (rr >> 1), p0 = 8 * (rr & 1) + 4 * h;
                    const u32x2 uw = uwv[rr]; const f32x4 d4 = (rr & 1) ? dB : dA;
                    const float y0 = acc[4 * rr] + d4[0] * bf_lo(uw.x), y1 = acc[4 * rr + 1] + d4[1] * bf_hi(uw.x);
                    const float y2 = acc[4 * rr + 2] + d4[2] * bf_lo(uw.y), y3 = acc[4 * rr + 3] + d4[3] * bf_hi(uw.y);
                    u32x2 o; o.x = cvt_pk_bf16(gelu_tanh_f(y0), gelu_tanh_f(y1)); o.y = cvt_pk_bf16(gelu_tanh_f(y2), gelu_tanh_f(y3));
                    *(u32x2*)(gbase + ((size_t)seg * (SEGC * TCH) + ch * TCH + jj) * 16 + p0) = o; }
            }
        }
        __syncthreads();
    }
}

__device__ void phase_final() {
    const ParamsPtr pq = params_ptr(); struct { const float* in[3]; float* out; unsigned char* ws; } p{{pq->in[0], pq->in[1], pq->in[2]}, pq->out, pq->ws};
    const float* rowss = (const float*)(p.ws + WS_ROWSS) + 4 * M_TOK; const float* gf = p.in[2];
    const int tid = fresh_tid(), lane = tid & 63, wave = tid >> 6;
    for (int row = blockIdx.x * 8 + wave; row < M_TOK; row += gridDim.x * 8) {
        const float inv = rsqrtf(rowss[row] * (1.0f / DM) + EPS); float4* xr = (float4*)(p.out + (size_t)row * DM);
        float4 xv[8], gv[8];
#pragma unroll
        for (int i = 0; i < 8; ++i) { xv[i] = xr[i * 64 + lane]; gv[i] = ((const float4*)gf)[i * 64 + lane]; }
#pragma unroll
        for (int i = 0; i < 8; ++i) { float4 v = xv[i]; const float4 g = gv[i];
            v.x *= inv * g.x; v.y *= inv * g.y; v.z *= inv * g.z; v.w *= inv * g.w; xr[i * 64 + lane] = v; }
    }
}

#define XB_TMO      128
#define XB_XCNT(j)  (256  + 64 * (j))
#define XB_XSUB(j)  (1280 + 64 * (j))
#define XB_XGEN(j)  (2304 + 64 * (j))
#define XB_TOP      3328
#define XB_TOPGEN   3392
#define XCD_BAR_WORDS 3456
#define XB_SPIN_CAP (1u << 18)
__device__ __forceinline__ unsigned xb_ld(unsigned* p)              { return __hip_atomic_load(p, __ATOMIC_RELAXED, __HIP_MEMORY_SCOPE_AGENT); }
__device__ __forceinline__ unsigned xb_add(unsigned* p, unsigned v) { return __hip_atomic_fetch_add(p, v, __ATOMIC_RELAXED, __HIP_MEMORY_SCOPE_AGENT); }
__device__ __forceinline__ unsigned xb_xcc_id() { return (unsigned)__builtin_amdgcn_s_getreg((3 << 11) | 20) & 0xFu; }
#define XB_SPIN(cond, bar) do { unsigned _sp = 0; while (cond) { __builtin_amdgcn_s_sleep(1); \
    if ((++_sp & 255u) == 0u) { if (xb_ld(&(bar)[XB_TMO])) break; if (_sp > XB_SPIN_CAP) { atomicAdd(&(bar)[XB_TMO], 1u); break; } } } } while (0)
struct XcdBarrier { unsigned* bar; unsigned x; volatile LAS unsigned* st; };
__device__ __forceinline__ XcdBarrier xcd_barrier_post(unsigned* bar, volatile LAS unsigned* st) {
    XcdBarrier b; b.bar = bar; b.x = xb_xcc_id(); b.st = st;
    if (threadIdx.x == 0) (void)xb_add(&bar[XB_XCNT(b.x)], 1u);
    return b;
}
__device__ __forceinline__ void xcd_barrier_complete(unsigned* bar, unsigned x, unsigned& nloc, unsigned& nx) {
    const unsigned G = gridDim.x * gridDim.y * gridDim.z;
    unsigned sum, cnt, mine, sp = 0u;
    for (;;) {
        sum = 0u; cnt = 0u; mine = 0u;
#pragma unroll
        for (unsigned j = 0; j < 16; ++j) { const unsigned c = xb_ld(&bar[XB_XCNT(j)]); sum += c; cnt += (c > 0u) ? 1u : 0u; mine = (j == x) ? c : mine; }
        if (sum == G) break;
        __builtin_amdgcn_s_sleep(1);
        if ((++sp & 255u) == 0u) { if (xb_ld(&bar[XB_TMO])) break; if (sp > XB_SPIN_CAP) { atomicAdd(&bar[XB_TMO], 1u); break; } }
    }
    nloc = mine > 0u ? mine : 1u; nx = cnt > 0u ? cnt : 1u;
}
__device__ __forceinline__ void xcd_barrier(const XcdBarrier& b) {
    asm volatile("s_waitcnt vmcnt(0)" ::: "memory");
    __syncthreads();
    if (threadIdx.x == 0) {
        unsigned* bar = b.bar;
        __builtin_amdgcn_s_waitcnt(0);
        unsigned nloc = b.st[0], nx = b.st[1];
        if (nloc == 0u) { xcd_barrier_complete(bar, b.x, nloc, nx); b.st[0] = nloc; b.st[1] = nx; }
        const unsigned old = xb_add(&bar[XB_XSUB(b.x)], 1u);
        const unsigned gen = old / nloc;
        if (old + 1u == (gen + 1u) * nloc) {
            __builtin_amdgcn_fence(__ATOMIC_RELEASE, "agent");
            asm volatile("s_waitcnt vmcnt(0)" ::: "memory");
            const unsigned og = xb_add(&bar[XB_TOP], 1u);
            const unsigned tg = og / nx;
            if (og + 1u == (tg + 1u) * nx) xb_add(&bar[XB_TOPGEN], 1u);
            else XB_SPIN(xb_ld(&bar[XB_TOPGEN]) == tg, bar);
            __builtin_amdgcn_fence(__ATOMIC_ACQUIRE, "agent");
            xb_add(&bar[XB_XGEN(b.x)], 1u);
            asm volatile("s_waitcnt vmcnt(0)" ::: "memory");
        } else {
            XB_SPIN(xb_ld(&bar[XB_XGEN(b.x)]) == gen, bar);
            __builtin_amdgcn_fence(__ATOMIC_ACQUIRE, "agent");
            asm volatile("s_waitcnt vmcnt(0)" ::: "memory");
        }
    }
    __syncthreads();
}

constexpr int N_PHASES_K = 18;
__global__ void __launch_bounds__(NTHREADS, 2) fwd_megakernel(Params p_unused) {
    extern __shared__ __attribute__((aligned(16))) unsigned char lds[];
    LAS unsigned char* ldsl = (LAS unsigned char*)lds;
    float* ldsf = (float*)lds;
    cg::grid_group grid = cg::this_grid();
    const int lo = params_ptr()->ph_lo, hi = params_ptr()->ph_hi;
    const int G = gridDim.x, bx = blockIdx.x;
    int ph = 0;
    volatile LAS unsigned* xbst = (volatile LAS unsigned*)(ldsl + XB_LDS_OFF);
    if (threadIdx.x < 4) xbst[threadIdx.x] = 0u;
    __syncthreads();
    XcdBarrier xbar; xbar.bar = (unsigned*)(params_ptr()->ws + WS_BAR); xbar.x = 0; xbar.st = xbst;
    if (hi - lo > 1) xbar = xcd_barrier_post((unsigned*)(params_ptr()->ws + WS_BAR), xbst);
    const bool pretab = (G == NG) && (hi - lo == N_PHASES_K);
    const bool fusefin = (G == 256) && (hi - lo == N_PHASES_K);
#define SEAM() do { if (lo <= ph && ph + 1 < hi && !(fusefin && ph == N_PHASES_K - 2)) { if (hi > N_PHASES_K) grid.sync(); else xcd_barrier(xbar); } ++ph; } while (0)
#define RUN (lo <= ph && ph < hi)
#define WSP(off) ((bf16_t*)(q->ws + (off)))
    if (RUN) phase_prep(ldsf);
    SEAM();
#pragma unroll 1
    for (int l = 0; l < 4; ++l) {
        const int j = l >> 1; const bool ssm = (l & 1);
        const size_t wofs = ssm ? WS_WSSM + j * W_SSM_SZ : WS_W + j * W_POOL_SZ;
        if (RUN) { const ParamsPtr q = params_ptr(); pg8::Gemm g{WSP(WS_HBF), WSP(wofs), M_TOK, DE2, DM, 2u * DM, 32u, 128u, 0}; pg8::StaticOrder S; S.init(M_TOK, DE2, G, bx);
            pg8::EpiIn E{WSP(WS_UZ), (const float*)(q->ws + WS_ROWSS) + l * M_TOK, ssm ? WSP(WS_GATED) : nullptr}; pg8::gemm_phase<pg8::EpiIn>(ldsl, g, S, E);
            if (ssm && pretab) ssm_tables(j, bx, lds); }
        SEAM();
        if (!ssm) {
            if (RUN) phase_pool();
            SEAM();
            if (RUN) { const ParamsPtr q = params_ptr(); pg8::Gemm g{WSP(WS_PG), WSP(wofs + W_POOL_GRP), M_TOK, DE, 1024, 2u * DE, 32u, 128u, 1}; pg8::StaticOrder S; S.init(M_TOK, DE, G, bx);
                pg8::EpiPool E{WSP(WS_GATED), WSP(WS_UZ) + DE, q->in[5] + (size_t)j * DE}; pg8::gemm_phase<pg8::EpiPool>(ldsl, g, S, E); }
            SEAM();
        } else {
            if (RUN) phase_ssm(j, lds, pretab);
            SEAM();
            if (RUN) { const ParamsPtr q = params_ptr(); pg8::Gemm g{WSP(WS_PG), WSP(wofs + W_SSM_GLU), M_TOK, DE, DE, 32u, 2u * GSTR, 8u * GSTR, 0}; pg8::StaticOrder S; S.init(M_TOK, DE, G, bx);
                pg8::EpiGlu E{WSP(WS_GATED), WSP(WS_UZ) + DE, WSP(WS_PG), q->in[17] + (size_t)j * DE}; pg8::gemm_phase<pg8::EpiGlu>(ldsl, g, S, E); }
            SEAM();
        }
        if (RUN && fusefin && l == 3) { const ParamsPtr q = params_ptr(); pg8::Gemm g{WSP(WS_GATED), WSP(wofs + W_SSM_OUT), M_TOK, DM, DE, 2u * DE, 32u, 128u, 0}; pg8::StaticOrder S; S.init(M_TOK, DM, G, bx);
            pg8::EpiOutFinal E{(const float*)q->out, q->out, q->in[2], (float*)(q->ws + WS_ROWSS) + 4 * M_TOK, (unsigned*)(q->ws + WS_PCNT)}; pg8::gemm_phase<pg8::EpiOutFinal>(ldsl, g, S, E); }
        else if (RUN) { const ParamsPtr q = params_ptr(); pg8::Gemm g{WSP(WS_GATED), WSP(wofs + (ssm ? W_SSM_OUT : W_POOL_OUT)), M_TOK, DM, DE, 2u * DE, 32u, 128u, 0}; pg8::StaticOrder S; S.init(M_TOK, DM, G, bx);
            pg8::EpiOut E{(l == 0) ? q->in[0] : (const float*)q->out, q->out, (l < 3) ? WSP(WS_HBF) : nullptr, q->in[1] + (size_t)(l < 3 ? l + 1 : 0) * DM, (float*)(q->ws + WS_ROWSS) + (l + 1) * M_TOK}; pg8::gemm_phase<pg8::EpiOut>(ldsl, g, S, E); }
        SEAM();
    }
    if (RUN && !fusefin) phase_final();
#undef SEAM
#undef RUN
#undef WSP
}
constexpr int N_PHASES = 18;

extern "C" void kernel_launch(void* const* d_in, const int* in_sizes, int n_in, void* d_out, int out_size, void* d_ws, size_t ws_size, hipStream_t stream) {
    static int grid = 0;
    if (grid == 0) {
        if (n_in != 19 || out_size != M_TOK * DM || ws_size < WS_END) { fprintf(stderr, "kernel_launch: unexpected shapes (n_in %d out %d ws %zu need %zu)\n", n_in, out_size, ws_size, (size_t)WS_END); grid = -1; return; }
        int dev = 0, cus = 0, per_cu = 0;
        hipGetDevice(&dev); hipDeviceGetAttribute(&cus, hipDeviceAttributeMultiprocessorCount, dev);
        if (hipFuncSetAttribute((const void*)fwd_megakernel, hipFuncAttributeMaxDynamicSharedMemorySize, LDS_BYTES) != hipSuccess) { fprintf(stderr, "kernel_launch: hipFuncSetAttribute failed\n"); grid = -1; return; }
        hipOccupancyMaxActiveBlocksPerMultiprocessor(&per_cu, (const void*)fwd_megakernel, NTHREADS, LDS_BYTES);
        if (per_cu < 1) { fprintf(stderr, "kernel_launch: occupancy query says %d blocks per CU\n", per_cu); per_cu = 1; }
        (void)hipGetLastError();
        grid = cus;
    }
    if (grid < 0) return;
    Params p{};
    for (int i = 0; i < 19; ++i) p.in[i] = (const float*)d_in[i];
    p.out = (float*)d_out; p.ws = (unsigned char*)d_ws;
#if ONE_LAUNCH
    p.ph_lo = 0; p.ph_hi = N_PHASES;
    if (hipMemsetAsync((char*)d_ws + WS_BAR, 0, 16 * 1024 + 32 * 256, stream) != hipSuccess) { fprintf(stderr, "kernel_launch: memset of barrier words failed\n"); return; }
    void* args[] = {&p};
    hipError_t e = hipLaunchCooperativeKernel((const void*)fwd_megakernel, dim3(grid), dim3(NTHREADS), args, LDS_BYTES, stream);
    if (e != hipSuccess) fprintf(stderr, "cooperative launch failed: %s (grid %d)\n", hipGetErrorString(e), grid);
#else
    for (int ph = 0; ph < N_PHASES; ++ph) { p.ph_lo = ph; p.ph_hi = ph + 1;
        hipLaunchKernelGGL(fwd_megakernel, dim3(grid), dim3(NTHREADS), LDS_BYTES, stream, p); }
#endif
}
```
